# Optimizing an MI355X kernel written in HIP

```python
import jax, jax.numpy as jnp
from jax import lax
import numpy as np

D_MODEL = 1024
BATCH = 1
SEQ = 16384
DEPTH = 2
DEC_BATCH = 8
DEC_SEQ = 16
PAST_LEN = 4096

CHUNK = 64
Q_BLOCK = 128
NORM_EPS = 1e-6
D_FF = 4 * D_MODEL

GDN_HEADS = 4
GDN_DK = 128
GDN_DV = 128
GDN_CONV = 4
GDN_QKV = GDN_HEADS * (2 * GDN_DK + GDN_DV)

FOX_HEADS = 4
FOX_DH = 128

IN0_SIZES = (GDN_QKV, GDN_HEADS * GDN_DV, GDN_HEADS, GDN_HEADS,
             FOX_HEADS * FOX_DH, FOX_HEADS * FOX_DH, FOX_HEADS * FOX_DH, FOX_HEADS)
IN0_COLS = sum(IN0_SIZES)
MIX0_WIDTH = GDN_HEADS * GDN_DV + FOX_HEADS * FOX_DH

RWKV_HEAD = 64
RWKV_HEADS = D_MODEL // RWKV_HEAD
RWKV_DECAY_LORA = 64
RWKV_A_LORA = 64
RWKV_GATE_LORA = 160
RWKV_GN_EPS = 1e-5 * RWKV_HEAD

F32 = jnp.float32

kernel_name = 'hybrid_stream_gdn_fox_rwkv7_step'


def _rms(x, g):
    xf = x.astype(F32)
    y = xf * lax.rsqrt(jnp.mean(xf * xf, axis=-1, keepdims=True) + NORM_EPS)
    return (y * g.astype(F32)).astype(x.dtype)


def _l2n(x):
    return x * lax.rsqrt(jnp.sum(x * x, axis=-1, keepdims=True) + NORM_EPS)


def _ada(c, w, b):
    m = jax.nn.silu(c) @ w + b
    return [t[:, None, :] for t in jnp.split(m, 6, axis=-1)]


def _split_cols(t, sizes):
    offs, acc = [], 0
    for s in sizes[:-1]:
        acc += s
        offs.append(acc)
    return jnp.split(t, offs, axis=-1)


def _sqrelu_mlp(h, w1, w2):
    return jnp.square(jax.nn.relu(h @ w1)) @ w2


def _causal_conv(u, buf, w):
    L = u.shape[1]
    full = jnp.concatenate([buf.astype(u.dtype), u], axis=1)
    y = full[:, 0:L] * w[0]
    for i in range(1, GDN_CONV):
        y = y + full[:, i:i + L] * w[i]
    return jax.nn.silu(y), full[:, L:]


def _gdn_chunk_terms(q, k, v, beta, g):
    l = q.shape[2]
    tri = jnp.tril(jnp.ones((l, l), bool))
    strict = jnp.tril(jnp.ones((l, l), bool), -1)
    gc = jnp.cumsum(g, axis=2)
    gch = jnp.swapaxes(gc, 2, 3)
    diff = gch[..., :, None] - gch[..., None, :]
    dec = jnp.where(tri, jnp.exp(jnp.where(tri, diff, 0.0)), 0.0)
    kk = jnp.einsum('bnihd,bnjhd->bnhij', k, k)
    betah = jnp.swapaxes(beta, 2, 3)
    a_strict = jnp.where(strict, betah[..., :, None] * kk * dec, 0.0)
    rhs = jnp.concatenate([v * beta[..., None], k * (beta * jnp.exp(gc))[..., None]], axis=-1)
    rhs = jnp.swapaxes(rhs, 2, 3)
    sol = lax.linalg.triangular_solve(a_strict, rhs, left_side=True, lower=True, unit_diagonal=True)
    u_val, w_k = sol[..., :GDN_DV], sol[..., GDN_DV:]
    qk = jnp.einsum('bnihd,bnjhd->bnhij', q, k) * dec
    q_dec = jnp.swapaxes(q * jnp.exp(gc)[..., None], 2, 3)
    k_tail = jnp.swapaxes(k * jnp.exp(gc[:, :, -1:] - gc)[..., None], 2, 3)
    g_last = gc[:, :, -1]
    return u_val, w_k, qk, q_dec, k_tail, g_last


def _gdn_scan(terms, s0):
    def step(s, t):
        u_val, w_k, qk, q_dec, k_tail, g_last = t
        u = u_val - jnp.einsum('bhlk,bhkv->bhlv', w_k, s)
        o = jnp.einsum('bhlk,bhkv->bhlv', q_dec, s) + jnp.einsum('bhij,bhjv->bhiv', qk, u)
        s = s * jnp.exp(g_last)[..., None, None] + jnp.einsum('bhlk,bhlv->bhkv', k_tail, u)
        return s, o
    s, o = lax.scan(step, s0, tuple(jnp.moveaxis(t, 1, 0) for t in terms))
    return jnp.moveaxis(o, 0, 1), s


def _gdn_mixer(qkv_raw, z, b_raw, a_raw, conv_buf, s0, conv_w, a_log, dt_bias, onorm):
    b, L, _ = qkv_raw.shape
    H, dk, dv = GDN_HEADS, GDN_DK, GDN_DV
    qkv, conv_new = _causal_conv(qkv_raw, conv_buf, conv_w)
    q, k, v = jnp.split(qkv, [H * dk, 2 * H * dk], axis=-1)
    q = _l2n(q.reshape(b, L, H, dk).astype(F32)) * dk ** -0.5
    k = _l2n(k.reshape(b, L, H, dk).astype(F32))
    v = v.reshape(b, L, H, dv).astype(F32)
    beta = jax.nn.sigmoid(b_raw.astype(F32))
    g = -jnp.exp(a_log.astype(F32)) * jax.nn.softplus(a_raw.astype(F32) + dt_bias.astype(F32))
    cl = min(L, CHUNK)
    n = L // cl
    blk = lambda t: t.reshape((b, n, cl) + t.shape[2:])
    terms = _gdn_chunk_terms(blk(q), blk(k), blk(v), blk(beta), blk(g))
    o, s_new = _gdn_scan(terms, s0.astype(F32))
    o = jnp.transpose(o, (0, 1, 3, 2, 4)).reshape(b, L, H, dv)
    o = _rms(o, onorm) * jax.nn.silu(z.reshape(b, L, H, dv).astype(F32))
    return o.reshape(b, L, H * dv).astype(z.dtype), conv_new, s_new


def _fox_prompt(q, k, v, logf):
    b, t, h, dh = q.shape
    nb = t // Q_BLOCK
    c = jnp.swapaxes(jnp.cumsum(logf, axis=1), 1, 2)
    qb = jnp.moveaxis(q.reshape(b, nb, Q_BLOCK, h, dh), 1, 0)
    cb = jnp.moveaxis(c.reshape(b, h, nb, Q_BLOCK), 2, 0)
    key_pos = jnp.arange(t)

    def block(args):
        qi, ci, i = args
        s = jnp.einsum('bqhd,bkhd->bhqk', qi, k, preferred_element_type=F32)
        s = s + ci[..., :, None] - c[..., None, :]
        qpos = i * Q_BLOCK + jnp.arange(Q_BLOCK)
        s = jnp.where(key_pos[None, :] <= qpos[:, None], s, -jnp.inf)
        p = jax.nn.softmax(s, axis=-1)
        return jnp.einsum('bhqk,bkhd->bqhd', p.astype(v.dtype), v)

    o = lax.map(block, (qb, cb, jnp.arange(nb)))
    return jnp.moveaxis(o, 0, 1).reshape(b, t, h, dh)


def _fox_step(q, k_new, v_new, logf_new, k_cache, v_cache, logf_cache):
    p_len = k_cache.shape[1]
    l = q.shape[1]
    k = jnp.concatenate([k_cache.astype(k_new.dtype), k_new], axis=1)
    v = jnp.concatenate([v_cache.astype(v_new.dtype), v_new], axis=1)
    c = jnp.cumsum(jnp.concatenate([logf_cache.astype(F32), logf_new], axis=1), axis=1)
    c = jnp.swapaxes(c, 1, 2)
    s = jnp.einsum('bqhd,bkhd->bhqk', q, k, preferred_element_type=F32)
    s = s + c[..., p_len:, None] - c[..., None, :]
    mask = jnp.arange(p_len + l)[None, :] <= (p_len + jnp.arange(l))[:, None]
    s = jnp.where(mask, s, -jnp.inf)
    p = jax.nn.softmax(s, axis=-1)
    return jnp.einsum('bhqk,bkhd->bqhd', p.astype(v.dtype), v)


def _hybrid_layer(x, c, conv_buf, s0, fox_cache, ada_w, ada_b, norm_mix, norm_ff, w_in, conv_w,
                  a_log, dt_bias, gdn_onorm, fox_qnorm, fox_knorm, fox_fbias, w_out, ff_w1, ff_w2):
    b, L, _ = x.shape
    sh1, sc1, gt1, sh2, sc2, gt2 = _ada(c, ada_w, ada_b)
    h = _rms(x, norm_mix) * (1 + sc1) + sh1
    proj = h @ w_in
    qkv_a, z_a, b_a, a_a, q_b, k_b, v_b, f_b = _split_cols(proj, IN0_SIZES)
    o_a, conv_new, s_new = _gdn_mixer(qkv_a, z_a, b_a, a_a, conv_buf, s0, conv_w, a_log, dt_bias, gdn_onorm)
    q = _rms(q_b.reshape(b, L, FOX_HEADS, FOX_DH), fox_qnorm) * FOX_DH ** -0.5
    k = _rms(k_b.reshape(b, L, FOX_HEADS, FOX_DH), fox_knorm)
    v = v_b.reshape(b, L, FOX_HEADS, FOX_DH)
    logf = jax.nn.log_sigmoid(f_b.astype(F32) + fox_fbias.astype(F32))
    if fox_cache is None:
        o_b = _fox_prompt(q, k, v, logf)
    else:
        o_b = _fox_step(q, k, v, logf, *fox_cache)
    mix = jnp.concatenate([o_a, o_b.reshape(b, L, FOX_HEADS * FOX_DH).astype(o_a.dtype)], axis=-1) @ w_out
    x = x + gt1 * mix
    h2 = _rms(x, norm_ff) * (1 + sc2) + sh2
    x = x + gt2 * _sqrelu_mlp(h2, ff_w1, ff_w2)
    return x, conv_new, s_new, k, v, logf


def _wkv7_scan(r, decay, k, v, kk, bvec, s0):
    def step(s, t):
        r_t, w_t, k_t, v_t, kk_t, b_t = t
        sa = -jnp.einsum('bhij,bhj->bhi', s, kk_t)
        s = (s * w_t[:, :, None, :] + sa[..., None] * b_t[:, :, None, :]
             + v_t[..., None] * k_t[:, :, None, :])
        return s, jnp.einsum('bhij,bhj->bhi', s, r_t)
    xs = tuple(jnp.moveaxis(t, 1, 0) for t in (r, decay, k, v, kk, bvec))
    s, y = lax.scan(step, s0, xs)
    return jnp.moveaxis(y, 0, 1), s


def _rwkv_layer(x, c, shift_prev, s0, ada_w, ada_b, norm_mix, norm_ff, mu, w_r, w_k, w_v,
                w0, w1, w2, a0, a1, a2, g1, g2, k_k, k_a, r_k, ln_w, ln_b, w_o, ff_w1, ff_w2):
    b, L, D = x.shape
    H, N = RWKV_HEADS, RWKV_HEAD
    sh1, sc1, gt1, sh2, sc2, gt2 = _ada(c, ada_w, ada_b)
    h = _rms(x, norm_mix) * (1 + sc1) + sh1
    h_prev = jnp.concatenate([shift_prev[:, None, :].astype(h.dtype), h[:, :-1]], axis=1)
    xx = h_prev - h
    xr, xw, xk, xv, xa, xg = [h + xx * mu[i] for i in range(6)]
    r = xr @ w_r
    k = xk @ w_k
    v = xv @ w_v
    w = -jax.nn.softplus(-(w0 + jnp.tanh(xw @ w1) @ w2).astype(F32)) - 0.5
    a = jax.nn.sigmoid((a0 + (xa @ a1) @ a2).astype(F32))
    gate = jax.nn.sigmoid(xg @ g1) @ g2
    heads = lambda t: t.astype(F32).reshape(b, L, H, N)
    kk = _l2n(heads(k * k_k))
    k = k.astype(F32) * (1 + (a - 1) * k_a.astype(F32))
    r_h, k_h, v_h, a_h = heads(r), heads(k), heads(v), heads(a)
    decay = jnp.exp(-jnp.exp(heads(w)))
    y, s_new = _wkv7_scan(r_h, decay, k_h, v_h, kk, kk * a_h, s0.astype(F32))
    mean = jnp.mean(y, axis=-1, keepdims=True)
    var = jnp.mean(jnp.square(y - mean), axis=-1, keepdims=True)
    y = ((y - mean) * lax.rsqrt(var + RWKV_GN_EPS)).reshape(b, L, D) * ln_w.astype(F32) + ln_b.astype(F32)
    bonus = jnp.sum(r_h * k_h * r_k.astype(F32), axis=-1, keepdims=True) * v_h
    y = (y + bonus.reshape(b, L, D)).astype(x.dtype)
    x = x + gt1 * ((y * gate) @ w_o)
    h2 = _rms(x, norm_ff) * (1 + sc2) + sh2
    x = x + gt2 * _sqrelu_mlp(h2, ff_w1, ff_w2)
    return x, h[:, -1], s_new


def setup_inputs(seed: int = 0) -> dict:
    key = jax.random.key(seed)
    ks = iter(jax.random.split(key, 64))
    D = D_MODEL

    def nrm(shape, s=1.0):
        return s * jax.random.normal(next(ks), shape, F32)

    def unif(shape, lo, hi):
        return jax.random.uniform(next(ks), shape, F32, minval=lo, maxval=hi)

    def gain(n):
        return 1.0 + nrm((n,), 0.02)

    inp = {}
    inp['x_prompt'] = nrm((BATCH, SEQ, D))
    inp['x_sample'] = nrm((DEC_BATCH, DEC_SEQ, D))
    inp['c_prompt'] = nrm((BATCH, D))
    inp['c_sample'] = nrm((DEC_BATCH, D))
    inp['cache_l0_conv'] = nrm((DEC_BATCH, GDN_CONV - 1, GDN_QKV))
    inp['state_l0_delta'] = nrm((DEC_BATCH, GDN_HEADS, GDN_DK, GDN_DV), 0.5)
    inp['cache_l0_fox_k'] = nrm((DEC_BATCH, PAST_LEN, FOX_HEADS, FOX_DH))
    inp['cache_l0_fox_v'] = nrm((DEC_BATCH, PAST_LEN, FOX_HEADS, FOX_DH))
    inp['cache_l0_fox_logf'] = jax.nn.log_sigmoid(2.5 + nrm((DEC_BATCH, PAST_LEN, FOX_HEADS)))
    inp['state_l1_shift'] = nrm((DEC_BATCH, D))
    inp['state_l1_wkv'] = nrm((DEC_BATCH, RWKV_HEADS, RWKV_HEAD, RWKV_HEAD), 0.3)
    inp['l0_ada_w'] = nrm((D, 6 * D), 0.3 * D ** -0.5)
    inp['l0_ada_b'] = nrm((6 * D,), 0.02)
    inp['l0_norm_mix'] = gain(D)
    inp['l0_norm_ff'] = gain(D)
    inp['l0_w_in'] = nrm((D, IN0_COLS), D ** -0.5)
    inp['l0_conv_w'] = nrm((GDN_CONV, GDN_QKV), GDN_CONV ** -0.5)
    inp['l0_a_log'] = jnp.log(unif((GDN_HEADS,), 1.0, 16.0))
    dt = jnp.exp(unif((GDN_HEADS,), float(np.log(1e-3)), float(np.log(1e-1))))
    inp['l0_dt_bias'] = jnp.log(jnp.expm1(dt))
    inp['l0_gdn_onorm'] = gain(GDN_DV)
    inp['l0_fox_qnorm'] = gain(FOX_DH)
    inp['l0_fox_knorm'] = gain(FOX_DH)
    inp['l0_fox_fbias'] = 2.5 + nrm((FOX_HEADS,), 0.1)
    inp['l0_w_out'] = nrm((MIX0_WIDTH, D), MIX0_WIDTH ** -0.5)
    inp['l0_ff_w1'] = nrm((D, D_FF), D ** -0.5)
    inp['l0_ff_w2'] = nrm((D_FF, D), D_FF ** -0.5)
    inp['l1_ada_w'] = nrm((D, 6 * D), 0.3 * D ** -0.5)
    inp['l1_ada_b'] = nrm((6 * D,), 0.02)
    inp['l1_norm_mix'] = gain(D)
    inp['l1_norm_ff'] = gain(D)
    inp['l1_mu'] = unif((6, D), 0.0, 1.0)
    inp['l1_w_r'] = nrm((D, D), D ** -0.5)
    inp['l1_w_k'] = nrm((D, D), D ** -0.5)
    inp['l1_w_v'] = nrm((D, D), D ** -0.5)
    inp['l1_w0'] = unif((D,), -6.0, -1.0)
    inp['l1_w1'] = nrm((D, RWKV_DECAY_LORA), D ** -0.5)
    inp['l1_w2'] = nrm((RWKV_DECAY_LORA, D), 0.1 * RWKV_DECAY_LORA ** -0.5)
    inp['l1_a0'] = nrm((D,), 0.1)
    inp['l1_a1'] = nrm((D, RWKV_A_LORA), D ** -0.5)
    inp['l1_a2'] = nrm((RWKV_A_LORA, D), 0.1 * RWKV_A_LORA ** -0.5)
    inp['l1_g1'] = nrm((D, RWKV_GATE_LORA), D ** -0.5)
    inp['l1_g2'] = nrm((RWKV_GATE_LORA, D), RWKV_GATE_LORA ** -0.5)
    inp['l1_k_k'] = 0.85 + nrm((D,), 0.02)
    inp['l1_k_a'] = gain(D)
    inp['l1_r_k'] = nrm((RWKV_HEADS, RWKV_HEAD), 0.1)
    inp['l1_ln_w'] = gain(D)
    inp['l1_ln_b'] = nrm((D,), 0.01)
    inp['l1_w_o'] = nrm((D, D), D ** -0.5)
    inp['l1_ff_w1'] = nrm((D, D_FF), D ** -0.5)
    inp['l1_ff_w2'] = nrm((D_FF, D), D_FF ** -0.5)
    return inp


def reference(x_prompt, x_sample, c_prompt, c_sample, cache_l0_conv, state_l0_delta,
              cache_l0_fox_k, cache_l0_fox_v, cache_l0_fox_logf, state_l1_shift, state_l1_wkv,
              l0_ada_w, l0_ada_b, l0_norm_mix, l0_norm_ff, l0_w_in, l0_conv_w, l0_a_log, l0_dt_bias,
              l0_gdn_onorm, l0_fox_qnorm, l0_fox_knorm, l0_fox_fbias, l0_w_out, l0_ff_w1, l0_ff_w2,
              l1_ada_w, l1_ada_b, l1_norm_mix, l1_norm_ff, l1_mu, l1_w_r, l1_w_k, l1_w_v,
              l1_w0, l1_w1, l1_w2, l1_a0, l1_a1, l1_a2, l1_g1, l1_g2, l1_k_k, l1_k_a, l1_r_k,
              l1_ln_w, l1_ln_b, l1_w_o, l1_ff_w1, l1_ff_w2):
    even_layers = [(l0_ada_w, l0_ada_b, l0_norm_mix, l0_norm_ff, l0_w_in, l0_conv_w, l0_a_log, l0_dt_bias,
                    l0_gdn_onorm, l0_fox_qnorm, l0_fox_knorm, l0_fox_fbias, l0_w_out, l0_ff_w1, l0_ff_w2)]
    odd_layers = [(l1_ada_w, l1_ada_b, l1_norm_mix, l1_norm_ff, l1_mu, l1_w_r, l1_w_k, l1_w_v,
                   l1_w0, l1_w1, l1_w2, l1_a0, l1_a1, l1_a2, l1_g1, l1_g2, l1_k_k, l1_k_a, l1_r_k,
                   l1_ln_w, l1_ln_b, l1_w_o, l1_ff_w1, l1_ff_w2)]
    y_prompt, y_sample = x_prompt, x_sample
    bp = x_prompt.shape[0]
    for layer in range(DEPTH):
        if layer % 2 == 0:
            prm = even_layers[layer // 2]
            y_prompt, conv_p, delta_p, fox_k_p, fox_v_p, fox_logf_p = _hybrid_layer(
                y_prompt, c_prompt,
                jnp.zeros((bp, GDN_CONV - 1, GDN_QKV), y_prompt.dtype),
                jnp.zeros((bp, GDN_HEADS, GDN_DK, GDN_DV), F32),
                None, *prm)
            y_sample, conv_s, delta_s, fox_k_s, fox_v_s, fox_logf_s = _hybrid_layer(
                y_sample, c_sample, cache_l0_conv, state_l0_delta,
                (cache_l0_fox_k, cache_l0_fox_v, cache_l0_fox_logf), *prm)
        else:
            prm = odd_layers[layer // 2]
            y_prompt, shift_p, wkv_p = _rwkv_layer(
                y_prompt, c_prompt, jnp.zeros((bp, D_MODEL), y_prompt.dtype),
                jnp.zeros((bp, RWKV_HEADS, RWKV_HEAD, RWKV_HEAD), F32), *prm)
            y_sample, shift_s, wkv_s = _rwkv_layer(
                y_sample, c_sample, state_l1_shift, state_l1_wkv, *prm)
    return (y_prompt, y_sample, conv_p, conv_s, delta_p, delta_s, fox_k_p, fox_k_s,
            fox_v_p, fox_v_s, fox_logf_p, fox_logf_s, shift_p, shift_s, wkv_p, wkv_s)
```

```cpp
#include <hip/hip_runtime.h>
#include <hip/hip_cooperative_groups.h>
#include <cstdio>
#include <cstdint>
namespace cg = cooperative_groups;
#ifndef PM
#define PM 255
#endif

#define DEV __device__ __forceinline__
typedef unsigned short bf16_t;
typedef short bf16x8 __attribute__((ext_vector_type(8)));
typedef float f32x2 __attribute__((ext_vector_type(2)));
typedef float f32x4 __attribute__((ext_vector_type(4)));
typedef float f32x16 __attribute__((ext_vector_type(16)));
typedef unsigned u32x2 __attribute__((ext_vector_type(2)));
typedef unsigned u32x4 __attribute__((ext_vector_type(4)));
typedef __bf16 bf2_t __attribute__((ext_vector_type(2)));

constexpr int D = 1024, TP = 16384, TS = 128, T = TP + TS, NS = 9, DFF = 4096;
constexpr int NWIN = 3712;
constexpr int NPROJ = 3584;
constexpr float LOG2E = 1.4426950408889634f;
constexpr int NTHREADS = 256;
constexpr int SMEM_BYTES = 57344 + 1024;

constexpr size_t OUT_Y = 0;
constexpr size_t OUT_CONV = OUT_Y + (size_t)T * D;
constexpr size_t OUT_DELTA = OUT_CONV + 9ull * 3 * 1536;
constexpr size_t OUT_FK = OUT_DELTA + 9ull * 4 * 128 * 128;
constexpr size_t OUT_FV = OUT_FK + (size_t)T * 512;
constexpr size_t OUT_LOGF = OUT_FV + (size_t)T * 512;
constexpr size_t OUT_SHIFT = OUT_LOGF + (size_t)T * 4;
constexpr size_t OUT_WKV = OUT_SHIFT + 9ull * 1024;
constexpr size_t OUT_TOTAL = OUT_WKV + 9ull * 16 * 64 * 64;

constexpr size_t al256(size_t x) { return (x + 255) & ~(size_t)255; }
constexpr size_t O_WIN = 0;
constexpr size_t O_WOUT = O_WIN + (size_t)NWIN * 1024 * 2;
constexpr size_t O_FF1_0 = O_WOUT + 1024ull * 1024 * 2;
constexpr size_t O_FF2_0 = O_FF1_0 + 4096ull * 1024 * 2;
constexpr size_t O_RKV = O_FF2_0 + 4096ull * 1024 * 2;
constexpr size_t O_LORA1 = O_RKV + 3072ull * 1024 * 2;
constexpr size_t O_W2 = O_LORA1 + 512ull * 1024 * 2;
constexpr size_t O_A2 = O_W2 + 1024ull * 64 * 2;
constexpr size_t O_G2 = O_A2 + 1024ull * 64 * 2;
constexpr size_t O_WO = O_G2 + 1024ull * 192 * 2;
constexpr size_t O_FF1_1 = O_WO + 1024ull * 1024 * 2;
constexpr size_t O_FF2_1 = O_FF1_1 + 4096ull * 1024 * 2;
constexpr size_t O_MOD = O_FF2_1 + 4096ull * 1024 * 2;
constexpr size_t O_CTR = O_MOD + 2ull * 9 * 6144 * 4;
constexpr size_t O_TOT = O_CTR + 256;
constexpr size_t O_CL = al256(O_TOT + 129 * 16);
constexpr size_t O_PAB = al256(O_CL + (size_t)T * 16);
constexpr size_t O_GL = al256(O_PAB + (size_t)T * 64);
constexpr size_t O_BAR = al256(O_GL + 8192);
constexpr size_t O_R1 = al256(O_BAR + 16384);
constexpr size_t R1_BYTES = 34ull << 20;
constexpr size_t O_R2 = O_R1 + R1_BYTES;
constexpr size_t O_PROJ = O_R2;
constexpr size_t O_GIMG = al256(O_PROJ + (size_t)T * NPROJ * 2);
constexpr int GITEMS = 264 * 4;
constexpr size_t GIMG_BYTES = 73728;
constexpr size_t O_ORAW = al256(O_GIMG + (size_t)GITEMS * GIMG_BYTES);
constexpr size_t L0_END = O_ORAW + (size_t)T * 512 * 4;
constexpr size_t O_HID = O_R2;
constexpr size_t O_RKVB = O_R2;
constexpr size_t O_LW = al256(O_RKVB + (size_t)T * 3072 * 2);
constexpr size_t O_LA = al256(O_LW + (size_t)T * 64 * 2);
constexpr size_t O_LG = al256(O_LA + (size_t)T * 64 * 2);
constexpr size_t O_DEC = al256(O_LG + (size_t)T * 192 * 2);
constexpr size_t O_AB = al256(O_DEC + (size_t)T * 1024 * 4);
constexpr size_t O_GATE = al256(O_AB + (size_t)T * 1024 * 2);
constexpr size_t L1_END = O_GATE + (size_t)T * 1024 * 2;
constexpr size_t HID_END = O_HID + (size_t)T * 4096 * 2;
constexpr size_t WS_NEED = (L0_END > L1_END ? (L0_END > HID_END ? L0_END : HID_END) : (L1_END > HID_END ? L1_END : HID_END));

struct P { const float* in[50]; float* out; char* ws; };

DEV unsigned pk2(float a, float b) { f32x2 v = {a, b}; bf2_t r = __builtin_convertvector(v, bf2_t); return __builtin_bit_cast(unsigned, r); }
DEV bf16_t f2bf(float a) { return (bf16_t)(pk2(a, 0.f) & 0xffffu); }
DEV void st_bf4(bf16_t* p, const f32x4& v) { u32x2 o; o[0] = pk2(v[0], v[1]); o[1] = pk2(v[2], v[3]); *(u32x2*)p = o; }
DEV float bf2f(bf16_t b) { return __uint_as_float(((unsigned)b) << 16); }
DEV float bflo(unsigned u) { return __uint_as_float(u << 16); }
DEV float bfhi(unsigned u) { return __uint_as_float(u & 0xffff0000u); }
DEV int otid() { int t = threadIdx.x; asm volatile("" : "+v"(t)); return t; }
DEV float dpp_add(float x, const int ctrl_sel) {
  int xi = __float_as_int(x), yi;
  if (ctrl_sel == 0) yi = __builtin_amdgcn_update_dpp(0, xi, 0xB1, 0xF, 0xF, true);
  else if (ctrl_sel == 1) yi = __builtin_amdgcn_update_dpp(0, xi, 0x4E, 0xF, 0xF, true);
  else if (ctrl_sel == 2) yi = __builtin_amdgcn_update_dpp(0, xi, 0x141, 0xF, 0xF, true);
  else yi = __builtin_amdgcn_update_dpp(0, xi, 0x140, 0xF, 0xF, true);
  return x + __int_as_float(yi);
}
DEV float row16_sum(float x) { x = dpp_add(x, 0); x = dpp_add(x, 1); x = dpp_add(x, 2); x = dpp_add(x, 3); return x; }
DEV float wave_sum(float v) {
  v = row16_sum(v);
  const int vi = __float_as_int(v);
  const float a = __int_as_float(__builtin_amdgcn_readlane(vi, 0)), b = __int_as_float(__builtin_amdgcn_readlane(vi, 16));
  const float c = __int_as_float(__builtin_amdgcn_readlane(vi, 32)), d = __int_as_float(__builtin_amdgcn_readlane(vi, 48));
  return (a + b) + (c + d);
}
DEV float sigmoidf_(float x) { return 1.f / (1.f + __expf(-x)); }
DEV float siluf_(float x) { return x / (1.f + __expf(-x)); }
DEV float softplusf_(float x) { return x > 20.f ? x : log1pf(__expf(x)); }
DEV float logsigmoidf_(float x) { return fminf(x, 0.f) - log1pf(__expf(-fabsf(x))); }
DEV int stream_of(int row) { return row < TP ? 0 : 1 + ((row - TP) >> 4); }
DEV int perm16(int o) { return 8 * ((o >> 2) & 1) + (o & 3) + 4 * (o >> 3); }
DEV int crow(int i, int h) { return (i & 3) + 8 * (i >> 2) + 4 * h; }
DEV bf16x8 pack8(const f32x16& x, const int s) {
  u32x4 p;
  p[0] = pk2(x[8 * s + 0], x[8 * s + 1]); p[1] = pk2(x[8 * s + 2], x[8 * s + 3]);
  p[2] = pk2(x[8 * s + 4], x[8 * s + 5]); p[3] = pk2(x[8 * s + 6], x[8 * s + 7]);
  return __builtin_bit_cast(bf16x8, p);
}
#define LBAR() asm volatile("s_waitcnt lgkmcnt(0)\n\ts_barrier" ::: "memory")
#define MFMA32(a, b, c) __builtin_amdgcn_mfma_f32_32x32x16_bf16((a), (b), (c), 0, 0, 0)
DEV const float* xin_row(const P& p, int row) { return row < TP ? p.in[0] + (size_t)row * D : p.in[1] + (size_t)(row - TP) * D; }

constexpr int LDT = 144;

template <int MIX, int BN>
DEV void gemm_gload(const bf16_t* A, int lda, const bf16_t* B, int ldb, int m0, int n0, int k0, int tid,
                    u32x4 (&ra)[4], u32x4 (&rp)[4], f32x4 (&rm)[2], u32x4 (&rb)[BN / 32], const float* mu) {
  const int kc = tid & 7, r0 = tid >> 3;
#pragma unroll
  for (int i = 0; i < 4; ++i) {
    const int row = r0 + 32 * i;
    if (!MIX) {
      ra[i] = *(const u32x4*)(A + (size_t)(m0 + row) * lda + k0 + kc * 8);
    } else {
      const int t = m0 + row;
      const int pr = t < TP ? t + 1 : t + 2 + ((t - TP) >> 4);
      ra[i] = *(const u32x4*)(A + (size_t)pr * D + k0 + kc * 8);
      rp[i] = *(const u32x4*)(A + (size_t)(pr - 1) * D + k0 + kc * 8);
    }
  }
#pragma unroll
  for (int i = 0; i < BN / 32; ++i) rb[i] = *(const u32x4*)(B + (size_t)(n0 + r0 + 32 * i) * ldb + k0 + kc * 8);
  if (MIX) { rm[0] = *(const f32x4*)(mu + k0 + kc * 8); rm[1] = *(const f32x4*)(mu + k0 + kc * 8 + 4); }
}
template <int MIX, int BN>
DEV void gemm_lstore(char* sA, char* sB, int tid, const u32x4 (&ra)[4], const u32x4 (&rp)[4], const f32x4 (&rm)[2], const u32x4 (&rb)[BN / 32]) {
  const int kc = tid & 7, r0 = tid >> 3;
#pragma unroll
  for (int i = 0; i < 4; ++i) {
    u32x4 o = ra[i];
    if (MIX) {
#pragma unroll
      for (int e = 0; e < 4; ++e) {
        const float h0 = bflo(ra[i][e]), h1 = bfhi(ra[i][e]), p0 = bflo(rp[i][e]), p1 = bfhi(rp[i][e]);
        const float ma = (e < 2) ? rm[0][2 * e] : rm[1][2 * e - 4], mb = (e < 2) ? rm[0][2 * e + 1] : rm[1][2 * e - 3];
        o[e] = pk2(h0 + (p0 - h0) * ma, h1 + (p1 - h1) * mb);
      }
    }
    *(u32x4*)(sA + (r0 + 32 * i) * LDT + kc * 16) = o;
  }
#pragma unroll
  for (int i = 0; i < BN / 32; ++i) *(u32x4*)(sB + (r0 + 32 * i) * LDT + kc * 16) = rb[i];
}

struct PV { f32x4 a, b; };
struct NoPre { DEV PV operator()(int, int) const { PV z; z.a = (f32x4){0.f, 0.f, 0.f, 0.f}; z.b = z.a; return z; } };
template <int MIX, int BN = 128, class Epi, class Pre = NoPre>
DEV void gemm_tile(const bf16_t* A, int lda, const bf16_t* B, int ldb, int K, int m0, int n0, char* smem, const float* mu, Epi epi, Pre pre = Pre()) {
  constexpr int PD = BN == 256 ? 1 : (MIX ? 2 : 3);
  constexpr int NI = BN / 64;
  char* sA = smem; char* sB = smem + 128 * LDT;
  const int tid = otid(), lane = tid & 63, wid = tid >> 6, wr = wid >> 1, wc = wid & 1, h = lane >> 5, r = lane & 31;
  f32x16 acc[2][NI];
#pragma unroll
  for (int a = 0; a < 2; ++a)
#pragma unroll
    for (int b = 0; b < NI; ++b)
#pragma unroll
      for (int i = 0; i < 16; ++i) acc[a][b][i] = 0.f;
  u32x4 ra[PD][4], rp[PD][4], rb[PD][BN / 32]; f32x4 rm[PD][2];
  const int nk = K >> 6;
#pragma unroll
  for (int u = 0; u < PD; ++u) if (u < nk) gemm_gload<MIX, BN>(A, lda, B, ldb, m0, n0, u * 64, tid, ra[u], rp[u], rm[u], rb[u], mu);
  for (int kt0 = 0; kt0 < nk; kt0 += PD) {
#pragma unroll
    for (int u = 0; u < PD; ++u) {
      const int kt = kt0 + u;
      if (kt < nk) {
        LBAR();
        gemm_lstore<MIX, BN>(sA, sB, tid, ra[u], rp[u], rm[u], rb[u]);
        LBAR();
        if (kt + PD < nk) gemm_gload<MIX, BN>(A, lda, B, ldb, m0, n0, (kt + PD) * 64, tid, ra[u], rp[u], rm[u], rb[u], mu);
#pragma unroll
        for (int s = 0; s < 4; ++s) {
          const bf16x8 a0 = *(const bf16x8*)(sA + (wr * 64 + r) * LDT + s * 32 + h * 16);
          const bf16x8 a1 = *(const bf16x8*)(sA + (wr * 64 + 32 + r) * LDT + s * 32 + h * 16);
#pragma unroll
          for (int ni = 0; ni < NI; ++ni) {
            const bf16x8 bq = *(const bf16x8*)(sB + (wc * (BN / 2) + ni * 32 + r) * LDT + s * 32 + h * 16);
            acc[0][ni] = MFMA32(a0, bq, acc[0][ni]);
            acc[1][ni] = MFMA32(a1, bq, acc[1][ni]);
          }
        }
      }
    }
  }
  __builtin_amdgcn_sched_barrier(0);
  LBAR();
  constexpr int NIP = NI >= 2 ? 2 : 1;
  constexpr int SW = 32 * NIP + 4;
  constexpr int LPR = 8 * NIP;
  constexpr int RPI = 64 / LPR;
  float* stg = (float*)smem + wid * (32 * 68);
#pragma unroll
  for (int mi = 0; mi < 2; ++mi)
#pragma unroll
    for (int np = 0; np < NI / NIP; ++np) {
#pragma unroll
      for (int nn = 0; nn < NIP; ++nn)
#pragma unroll
        for (int i = 0; i < 16; ++i) stg[crow(i, h) * SW + 32 * nn + r] = acc[mi][np * NIP + nn][i];
#pragma unroll
      for (int it0 = 0; it0 < 32 / RPI; it0 += 4) {
        PV pv[4];
#pragma unroll
        for (int q = 0; q < 4; ++q) {
          const int rr = (it0 + q) * RPI + lane / LPR, c4 = (lane % LPR) * 4;
          pv[q] = pre(m0 + wr * 64 + mi * 32 + rr, n0 + wc * (BN / 2) + np * NIP * 32 + c4);
        }
#pragma unroll
        for (int q = 0; q < 4; ++q) {
          const int rr = (it0 + q) * RPI + lane / LPR, c4 = (lane % LPR) * 4;
          const f32x4 v = *(const f32x4*)(stg + rr * SW + c4);
          epi(m0 + wr * 64 + mi * 32 + rr, n0 + wc * (BN / 2) + np * NIP * 32 + c4, v, pv[q]);
        }
      }
    }
}

DEV void transpose_tile(const float* src, int ld, int kv, int c0, int cv, int special, bf16_t* dst, int ldd, int tt, char* smem) {
  const int tid = otid();
  const int nkt = ldd >> 6;
  const int n0 = (tt / nkt) * 64, k0 = (tt % nkt) * 64;
  float* tile = (float*)smem;
  const int nn = tid & 63;
  int scol; bool cvld;
  { const int gi = n0 + nn;
    if (special) { cvld = gi < 12; scol = gi < 8 ? 2048 + gi : 3592 + (gi - 8); }
    else { cvld = gi < cv; scol = c0 + gi; } }
  const int scl = cvld ? scol : 0;
  float tv[16];
#pragma unroll
  for (int i = 0; i < 16; ++i) {
    const int k = k0 + (tid >> 6) + 4 * i;
    tv[i] = src[(size_t)(k < kv ? k : kv - 1) * ld + scl];
  }
#pragma unroll
  for (int i = 0; i < 16; ++i) {
    const int kk = (tid >> 6) + 4 * i, k = k0 + kk;
    tile[kk * 65 + nn] = (cvld && k < kv) ? tv[i] : 0.f;
  }
  __syncthreads();
  const int kk2 = (tid & 31) * 2;
#pragma unroll
  for (int i = 0; i < 8; ++i) {
    const int nn2 = (tid >> 5) + 8 * i;
    *(unsigned*)(dst + (size_t)(n0 + nn2) * ldd + k0 + kk2) = pk2(tile[kk2 * 65 + nn2], tile[(kk2 + 1) * 65 + nn2]);
  }
}
constexpr int ADA_TASKS = 384;

DEV void phase0(const P& p, char* smem) {
  const int tid = otid();
  if (blockIdx.x == 0 && tid < 32) ((unsigned*)(p.ws + O_CTR))[tid] = 0u;
  if (blockIdx.x == 0 && tid == 64) {
    float mq = 0.f, mk = 0.f;
    for (int i = 0; i < 128; ++i) { mq = fmaxf(mq, fabsf(p.in[20][i])); mk = fmaxf(mk, fabsf(p.in[21][i])); }
    ((float*)(p.ws + O_CTR))[40] = 106.f + 2.f * mq * mk * 11.313708499f;
  }
  constexpr int ttiles = (2048/64)*16 + (1536/64)*16 + 2*16 + 16*16 + 64*16 + 16*64 + 3*16*16 + 2*16 + 2*16 + 4*16 + 16 + 16 + 16*3 + 16*16 + 64*16 + 16*64;
  const int total = ADA_TASKS + ttiles;
  for (int task = blockIdx.x; task < total; task += gridDim.x) {
    __syncthreads();
    if (task < ADA_TASKS) {
      const int layer = task / 192, j0 = (task % 192) * 32;
      const float* aw = layer ? p.in[26] : p.in[11]; const float* ab = layer ? p.in[27] : p.in[12];
      float* sc = (float*)smem;
      float* red = sc + 9 * 1024;
      for (int e = tid; e < 9 * 1024; e += NTHREADS) {
        const int s_ = e >> 10, k = e & 1023;
        const float c = s_ == 0 ? p.in[2][k] : p.in[3][(s_ - 1) * 1024 + k];
        sc[e] = siluf_(c);
      }
      __syncthreads();
      const int kp = tid >> 5, jj = tid & 31;
      float part[9];
#pragma unroll
      for (int s_ = 0; s_ < 9; ++s_) part[s_] = 0.f;
      const float* wp = aw + (size_t)(kp * 128) * 6144 + j0 + jj;
      for (int k0 = 0; k0 < 128; k0 += 16) {
        float wv[16];
#pragma unroll
        for (int u = 0; u < 16; ++u) wv[u] = wp[(size_t)(k0 + u) * 6144];
#pragma unroll
        for (int u = 0; u < 16; ++u)
#pragma unroll
          for (int s_ = 0; s_ < 9; ++s_) part[s_] += sc[s_ * 1024 + kp * 128 + k0 + u] * wv[u];
      }
#pragma unroll
      for (int s_ = 0; s_ < 9; ++s_) red[(kp * 9 + s_) * 32 + jj] = part[s_];
      __syncthreads();
      float* mod = (float*)(p.ws + O_MOD) + (size_t)layer * 9 * 6144;
      for (int o = tid; o < 288; o += NTHREADS) {
        const int s_ = o >> 5, j = o & 31;
        float v = ab[j0 + j];
#pragma unroll
        for (int q = 0; q < 8; ++q) v += red[(q * 9 + s_) * 32 + j];
        mod[s_ * 6144 + j0 + j] = v;
      }
    } else {
      int tt = task - ADA_TASKS;
      char* w = p.ws;
#define TRY_T(SRC, LD, KV, C0, CV, SP, DST, LDD, NROWS) { const int nt_ = ((NROWS) >> 6) * ((LDD) >> 6); if (tt >= 0 && tt < nt_) transpose_tile(SRC, LD, KV, C0, CV, SP, DST, LDD, tt, smem); tt -= nt_; }
      TRY_T(p.in[15], 3596, 1024, 0, 2048, 0, (bf16_t*)(w + O_WIN), 1024, 2048)
      TRY_T(p.in[15], 3596, 1024, 2056, 1536, 0, (bf16_t*)(w + O_WIN) + 2048 * 1024, 1024, 1536)
      TRY_T(p.in[15], 3596, 1024, 0, 12, 1, (bf16_t*)(w + O_WIN) + 3584 * 1024, 1024, 128)
      TRY_T(p.in[23], 1024, 1024, 0, 1024, 0, (bf16_t*)(w + O_WOUT), 1024, 1024)
      TRY_T(p.in[24], 4096, 1024, 0, 4096, 0, (bf16_t*)(w + O_FF1_0), 1024, 4096)
      TRY_T(p.in[25], 1024, 4096, 0, 1024, 0, (bf16_t*)(w + O_FF2_0), 4096, 1024)
      TRY_T(p.in[31], 1024, 1024, 0, 1024, 0, (bf16_t*)(w + O_RKV), 1024, 1024)
      TRY_T(p.in[32], 1024, 1024, 0, 1024, 0, (bf16_t*)(w + O_RKV) + 1024 * 1024, 1024, 1024)
      TRY_T(p.in[33], 1024, 1024, 0, 1024, 0, (bf16_t*)(w + O_RKV) + 2048 * 1024, 1024, 1024)
      TRY_T(p.in[35], 64, 1024, 0, 64, 0, (bf16_t*)(w + O_LORA1), 1024, 128)
      TRY_T(p.in[38], 64, 1024, 0, 64, 0, (bf16_t*)(w + O_LORA1) + 128 * 1024, 1024, 128)
      TRY_T(p.in[40], 160, 1024, 0, 160, 0, (bf16_t*)(w + O_LORA1) + 256 * 1024, 1024, 256)
      TRY_T(p.in[36], 1024, 64, 0, 1024, 0, (bf16_t*)(w + O_W2), 64, 1024)
      TRY_T(p.in[39], 1024, 64, 0, 1024, 0, (bf16_t*)(w + O_A2), 64, 1024)
      TRY_T(p.in[41], 1024, 160, 0, 1024, 0, (bf16_t*)(w + O_G2), 192, 1024)
      TRY_T(p.in[47], 1024, 1024, 0, 1024, 0, (bf16_t*)(w + O_WO), 1024, 1024)
      TRY_T(p.in[48], 4096, 1024, 0, 4096, 0, (bf16_t*)(w + O_FF1_1), 1024, 4096)
      TRY_T(p.in[49], 1024, 4096, 0, 1024, 0, (bf16_t*)(w + O_FF2_1), 4096, 1024)
    }
  }
}

DEV void rownorm_phase(const P& p, const float* src_or_null, const float* gain, int layer, int shidx, int scidx, bf16_t* dst, int mode) {
  const int tid_ = otid(); const int lane = tid_ & 63, wid = tid_ >> 6;
  const float* mod = (const float*)(p.ws + O_MOD) + (size_t)layer * 9 * 6144;
  const int nrows = mode == 1 ? T + 9 : T;
  for (int row = blockIdx.x * 4 + wid; row < nrows; row += gridDim.x * 4) {
    if (row >= T) {
      const int s = row - T;
      const int pr = s == 0 ? 0 : TP + 1 + 17 * (s - 1);
#pragma unroll
      for (int j = 0; j < 4; ++j) {
        const int c = lane * 4 + 256 * j;
        f32x4 v = {0.f, 0.f, 0.f, 0.f};
        if (s > 0) v = *(const f32x4*)(p.in[9] + (size_t)(s - 1) * D + c);
        u32x2 o; o[0] = pk2(v[0], v[1]); o[1] = pk2(v[2], v[3]);
        *(u32x2*)(dst + (size_t)pr * D + c) = o;
      }
      continue;
    }
    const float* src = src_or_null ? src_or_null + (size_t)row * D : xin_row(p, row);
    f32x4 v[4]; float ss = 0.f;
#pragma unroll
    for (int j = 0; j < 4; ++j) { v[j] = *(const f32x4*)(src + lane * 4 + 256 * j); ss += v[j][0] * v[j][0] + v[j][1] * v[j][1] + v[j][2] * v[j][2] + v[j][3] * v[j][3]; }
    ss = wave_sum(ss);
    const float rstd = rsqrtf(ss * (1.f / 1024.f) + 1e-6f);
    const int st = stream_of(row);
    const float* sh = mod + st * 6144 + shidx * 1024; const float* sc = mod + st * 6144 + scidx * 1024;
    size_t drow = row;
    if (mode == 1) drow = row < TP ? row + 1 : row + 2 + ((row - TP) >> 4);
    const bool last = mode == 1 && (row == TP - 1 || (row >= TP && ((row - TP) & 15) == 15));
    f32x4 gq[4], aq[4], bq_[4];
#pragma unroll
    for (int j = 0; j < 4; ++j) { const int c = lane * 4 + 256 * j; gq[j] = *(const f32x4*)(gain + c); aq[j] = *(const f32x4*)(sh + c); bq_[j] = *(const f32x4*)(sc + c); }
#pragma unroll
    for (int j = 0; j < 4; ++j) {
      const int c = lane * 4 + 256 * j;
      const f32x4 g = gq[j], a = aq[j], b = bq_[j];
      f32x4 o;
#pragma unroll
      for (int e = 0; e < 4; ++e) o[e] = v[j][e] * rstd * g[e] * (1.f + b[e]) + a[e];
      u32x2 ob; ob[0] = pk2(o[0], o[1]); ob[1] = pk2(o[2], o[3]);
      *(u32x2*)(dst + drow * D + c) = ob;
      if (last) *(f32x4*)(p.out + OUT_SHIFT + (size_t)st * D + c) = o;
    }
  }
}

DEV void fox_prep_tile(const P& p, int tile, char* smem) {
  const int tid = otid(), lane = tid & 63, wid = tid >> 6;
  float* lf = (float*)smem;
  bf16_t* proj = (bf16_t*)(p.ws + O_PROJ);
  const float* pab = (const float*)(p.ws + O_PAB);
  const float* qn = p.in[20]; const float* kn = p.in[21]; const float* fb = p.in[22];
  __syncthreads();
  for (int rr = wid * 32; rr < wid * 32 + 32; ++rr) {
    const int row = tile * 128 + rr;
    bf16_t* pr = proj + (size_t)row * NPROJ;
    unsigned uq[4], uk[4], uv[4];
#pragma unroll
    for (int hd = 0; hd < 4; ++hd) {
      const int c = hd * 128 + lane * 2;
      uq[hd] = *(const unsigned*)(pr + 2048 + c); uk[hd] = *(const unsigned*)(pr + 2560 + c); uv[hd] = *(const unsigned*)(pr + 3072 + c);
    }
    const float qn0 = qn[lane * 2], qn1 = qn[lane * 2 + 1], kn0 = kn[lane * 2], kn1 = kn[lane * 2 + 1];
#pragma unroll
    for (int hd = 0; hd < 4; ++hd) {
      const int c = hd * 128 + lane * 2;
      { const float a = bflo(uq[hd]), b = bfhi(uq[hd]);
        const float ss = wave_sum(a * a + b * b); const float rs = rsqrtf(ss * (1.f / 128.f) + 1e-6f) * 0.08838834764831845f * LOG2E;
        *(unsigned*)(pr + 2048 + c) = pk2(a * rs * qn0, b * rs * qn1); }
      { const float a = bflo(uk[hd]), b = bfhi(uk[hd]);
        const float ss = wave_sum(a * a + b * b); const float rs = rsqrtf(ss * (1.f / 128.f) + 1e-6f);
        f32x2 o = {a * rs * kn0, b * rs * kn1};
        *(f32x2*)(p.out + OUT_FK + (size_t)row * 512 + c) = o; }
      { f32x2 o = {bflo(uv[hd]), bfhi(uv[hd])};
        *(f32x2*)(p.out + OUT_FV + (size_t)row * 512 + c) = o; }
    }
    if (lane < 4) {
      const float f = logsigmoidf_(pab[(size_t)row * 16 + 8 + lane] + fb[lane]);
      p.out[OUT_LOGF + (size_t)row * 4 + lane] = f;
      lf[rr * 4 + lane] = f;
    }
  }
  __syncthreads();
  if (tid < 4) {
    float* cl = (float*)(p.ws + O_CL); float run = 0.f;
    for (int rr = 0; rr < 128; ++rr) { run += lf[rr * 4 + tid]; cl[(size_t)(tile * 128 + rr) * 4 + tid] = run; }
    ((float*)(p.ws + O_TOT))[tile * 4 + tid] = run;
  }
}

DEV int img_off128(int l, int k) {
  const int p = perm16(k & 15); const int cidx = (k >> 4) * 2 + (p >> 3);
  return l * 256 + ((cidx ^ (l & 15)) << 4) + (p & 7) * 2;
}
DEV int img_off64(int rowi, int j) {
  const int p = perm16(j & 15); const int cidx = (j >> 4) * 2 + (p >> 3);
  return rowi * 128 + ((cidx ^ ((rowi >> 1) & 7)) << 4) + (p & 7) * 2;
}

struct ConvCtx { const bf16_t* proj; const float* cache; const float* cw; int row0, L, first, stream; };
DEV float conv_raw(const ConvCtx& c, int rr, int ch) {
  if (rr >= 0) return bf2f(c.proj[(size_t)(c.row0 + rr) * NPROJ + ch]);
  if (!c.first) return bf2f(c.proj[(size_t)(c.row0 + rr) * NPROJ + ch]);
  if (c.stream == 0) return 0.f;
  return c.cache[((size_t)(c.stream - 1) * 3 + (3 + rr)) * 1536 + ch];
}

DEV void gdn_prep_item(const P& p, int item, char* smem) {
  const int tid = otid(), lane = tid & 63, wid = tid >> 6;
  const int ci = item >> 2, hd = item & 3;
  ConvCtx cc; cc.proj = (const bf16_t*)(p.ws + O_PROJ); cc.cache = p.in[4]; cc.cw = p.in[16];
  if (ci < 256) { cc.row0 = ci * 64; cc.L = 64; cc.stream = 0; cc.first = ci == 0; }
  else { cc.row0 = TP + (ci - 256) * 16; cc.L = 16; cc.stream = 1 + (ci - 256); cc.first = 1; }
  const int L = cc.L;
  float* ks = (float*)smem;
  float* As = ks + 64 * 132;
  float* sbeta = As + 64 * 68;
  float* sg = sbeta + 64, *sgc = sg + 64, *seg = sgc + 64;
  const float* pab = (const float*)(p.ws + O_PAB);
  char* img = p.ws + O_GIMG + (size_t)item * GIMG_BYTES;
  __syncthreads();
  {
    const int c = tid & 127, half = tid >> 7, ch = 512 + hd * 128 + c;
    const float w0 = cc.cw[ch], w1 = cc.cw[1536 + ch], w2 = cc.cw[2 * 1536 + ch], w3 = cc.cw[3 * 1536 + ch];
    const int rbeg = half * 32;
    float xr[35];
#pragma unroll
    for (int i = 0; i < 3; ++i) { const int rr = rbeg - 3 + i; xr[i] = (rr < L) ? conv_raw(cc, rr, ch) : 0.f; }
#pragma unroll
    for (int i = 3; i < 35; ++i) { const int rr = rbeg - 3 + i; const float t_ = bf2f(cc.proj[(size_t)(cc.row0 + (rr < L ? rr : L - 1)) * NPROJ + ch]); xr[i] = (rr < L) ? t_ : 0.f; }
#pragma unroll
    for (int i = 0; i < 32; ++i) {
      const int rr = rbeg + i; float o = 0.f;
      if (rr < L) o = siluf_(xr[i] * w0 + xr[i + 1] * w1 + xr[i + 2] * w2 + xr[i + 3] * w3);
      ks[rr * 132 + c] = o;
    }
  }
  if (tid < 64) {
    const int rr = tid; float be = 0.f, g = 0.f;
    if (rr < L) {
      const float braw = pab[(size_t)(cc.row0 + rr) * 16 + hd], araw = pab[(size_t)(cc.row0 + rr) * 16 + 4 + hd];
      be = sigmoidf_(braw); g = -__expf(p.in[17][hd]) * softplusf_(araw + p.in[18][hd]);
    }
    sbeta[rr] = be; sg[rr] = g;
  }
  __syncthreads();
  for (int rr = wid * 16; rr < wid * 16 + 16; ++rr) {
    const float a = ks[rr * 132 + lane], b = ks[rr * 132 + lane + 64];
    const float ss = wave_sum(a * a + b * b); const float rs = rsqrtf(ss + 1e-6f);
    ks[rr * 132 + lane] = a * rs; ks[rr * 132 + lane + 64] = b * rs;
  }
  if (tid == 0) {
    float run = 0.f;
    for (int rr = 0; rr < 64; ++rr) { run += sg[rr]; sgc[rr] = run; seg[rr] = __expf(run); }
    ((float*)(p.ws + O_GL))[item] = run;
  }
  __syncthreads();
  {
    const int ti = tid >> 4, tj = tid & 15;
    float acc[4][4];
#pragma unroll
    for (int a = 0; a < 4; ++a)
#pragma unroll
      for (int b = 0; b < 4; ++b) acc[a][b] = 0.f;
    for (int d = 0; d < 128; d += 4) {
      f32x4 ka[4], kb[4];
#pragma unroll
      for (int a = 0; a < 4; ++a) { ka[a] = *(const f32x4*)(ks + (ti + 16 * a) * 132 + d); kb[a] = *(const f32x4*)(ks + (tj + 16 * a) * 132 + d); }
#pragma unroll
      for (int a = 0; a < 4; ++a)
#pragma unroll
        for (int b = 0; b < 4; ++b) acc[a][b] += ka[a][0] * kb[b][0] + ka[a][1] * kb[b][1] + ka[a][2] * kb[b][2] + ka[a][3] * kb[b][3];
    }
#pragma unroll
    for (int a = 0; a < 4; ++a)
#pragma unroll
      for (int b = 0; b < 4; ++b) {
        const int i = ti + 16 * a, j = tj + 16 * b;
        As[i * 68 + j] = (j < i) ? sbeta[i] * acc[a][b] * __expf(sgc[i] - sgc[j]) : 0.f;
      }
  }
  __syncthreads();
  {
    float x[64];
    if (tid < 128) {
      const int c = tid, ch = 1024 + hd * 128 + c;
      const float w0 = cc.cw[ch], w1 = cc.cw[1536 + ch], w2 = cc.cw[2 * 1536 + ch], w3 = cc.cw[3 * 1536 + ch];
      float x0 = conv_raw(cc, -3, ch), x1 = conv_raw(cc, -2, ch), x2 = conv_raw(cc, -1, ch);
#pragma unroll
      for (int rr = 0; rr < 64; ++rr) x[rr] = bf2f(cc.proj[(size_t)(cc.row0 + (rr < L ? rr : L - 1)) * NPROJ + ch]);
#pragma unroll
      for (int rr = 0; rr < 64; ++rr) {
        const float x3 = x[rr];
        x[rr] = (rr < L) ? siluf_(x0 * w0 + x1 * w1 + x2 * w2 + x3 * w3) * sbeta[rr] : 0.f;
        x0 = x1; x1 = x2; x2 = x3;
      }
    } else {
      const int c = tid - 128;
#pragma unroll
      for (int rr = 0; rr < 64; ++rr) x[rr] = ks[rr * 132 + c] * sbeta[rr] * seg[rr];
    }
#pragma unroll
    for (int i = 1; i < 64; ++i) {
      float a = x[i];
#pragma unroll
      for (int j4 = 0; j4 < (i + 3) / 4; ++j4) {
        const f32x4 av = *(const f32x4*)(As + i * 68 + j4 * 4);
        a -= av[0] * x[4 * j4 + 0];
        if (4 * j4 + 1 < i) a -= av[1] * x[4 * j4 + 1];
        if (4 * j4 + 2 < i) a -= av[2] * x[4 * j4 + 2];
        if (4 * j4 + 3 < i) a -= av[3] * x[4 * j4 + 3];
      }
      x[i] = a;
      __builtin_amdgcn_sched_barrier(0);
    }
    if (tid < 128) {
      const int c = tid, w = c >> 5, ll = c & 31;
      bf16_t* uvb = (bf16_t*)(img + 57344) + (w * 128 + ll) * 16;
#pragma unroll
      for (int rr = 0; rr < 64; ++rr) {
        const int mt = rr >> 5, r5 = rr & 31, hh = (r5 >> 2) & 1, ii = (r5 & 3) + 4 * (r5 >> 3);
        uvb[(mt * 64 + 32 * hh) * 16 + ii] = f2bf(x[rr]);
        if ((rr & 7) == 7) __builtin_amdgcn_sched_barrier(0);
      }
    } else {
      const int c = tid - 128;
      const int pp = perm16(c & 15), cidx = (c >> 4) * 2 + (pp >> 3);
#pragma unroll
      for (int q = 0; q < 16; ++q) {
        char* bq = img + q * 256 + ((cidx ^ q) << 4) + (pp & 7) * 2;
#pragma unroll
        for (int g = 0; g < 4; ++g) *(bf16_t*)(bq + g * 4096) = f2bf(-x[16 * g + q]);
        __builtin_amdgcn_sched_barrier(0);
      }
    }
  }
  __syncthreads();
  float* qs = As;
  for (int hq = 0; hq < 2; ++hq) {
    {
      const int c = tid & 127, sub = tid >> 7, ch = hd * 128 + c;
      const float w0 = cc.cw[ch], w1 = cc.cw[1536 + ch], w2 = cc.cw[2 * 1536 + ch], w3 = cc.cw[3 * 1536 + ch];
      const int rbeg = hq * 32 + sub * 16;
      float xr[19];
#pragma unroll
      for (int i = 0; i < 3; ++i) { const int rr = rbeg - 3 + i; xr[i] = (rr < L) ? conv_raw(cc, rr, ch) : 0.f; }
#pragma unroll
      for (int i = 3; i < 19; ++i) { const int rr = rbeg - 3 + i; const float t_ = bf2f(cc.proj[(size_t)(cc.row0 + (rr < L ? rr : L - 1)) * NPROJ + ch]); xr[i] = (rr < L) ? t_ : 0.f; }
#pragma unroll
      for (int i = 0; i < 16; ++i) {
        const int rr = rbeg + i; float o = 0.f;
        if (rr < L) o = siluf_(xr[i] * w0 + xr[i + 1] * w1 + xr[i + 2] * w2 + xr[i + 3] * w3);
        qs[(rr - hq * 32) * 132 + c] = o;
      }
    }
    __syncthreads();
    for (int lr = wid * 8; lr < wid * 8 + 8; ++lr) {
      const float a = qs[lr * 132 + lane], b = qs[lr * 132 + lane + 64];
      const float ss = wave_sum(a * a + b * b); const float rs = rsqrtf(ss + 1e-6f) * 0.08838834764831845f;
      qs[lr * 132 + lane] = a * rs; qs[lr * 132 + lane + 64] = b * rs;
    }
    __syncthreads();
    {
      const int c = tid & 127, sub = tid >> 7;
      for (int i = 0; i < 16; ++i) {
        const int lr = sub * 16 + i, rr = hq * 32 + lr;
        *(bf16_t*)(img + 16384 + img_off128(rr, c)) = f2bf(qs[lr * 132 + c] * seg[rr]);
      }
      const int ti = tid >> 4, tj = tid & 15;
      float acc[2][4];
#pragma unroll
      for (int a = 0; a < 2; ++a)
#pragma unroll
        for (int b = 0; b < 4; ++b) acc[a][b] = 0.f;
      for (int d = 0; d < 128; d += 4) {
        f32x4 qa[2], kb[4];
#pragma unroll
        for (int a = 0; a < 2; ++a) qa[a] = *(const f32x4*)(qs + (ti + 16 * a) * 132 + d);
#pragma unroll
        for (int b = 0; b < 4; ++b) kb[b] = *(const f32x4*)(ks + (tj + 16 * b) * 132 + d);
#pragma unroll
        for (int a = 0; a < 2; ++a)
#pragma unroll
          for (int b = 0; b < 4; ++b) acc[a][b] += qa[a][0] * kb[b][0] + qa[a][1] * kb[b][1] + qa[a][2] * kb[b][2] + qa[a][3] * kb[b][3];
      }
#pragma unroll
      for (int a = 0; a < 2; ++a)
#pragma unroll
        for (int b = 0; b < 4; ++b) {
          const int i = hq * 32 + ti + 16 * a, j = tj + 16 * b;
          const float v = (j <= i) ? acc[a][b] * __expf(sgc[i] - sgc[j]) : 0.f;
          *(bf16_t*)(img + 32768 + img_off64(i, j)) = f2bf(v);
        }
    }
    __syncthreads();
  }
  {
    const int c = tid & 127, lb = (tid >> 7) * 32;
    const float glast = sgc[63];
    for (int i = 0; i < 32; ++i) {
      const int l = lb + i;
      *(bf16_t*)(img + 40960 + img_off64(c, l)) = f2bf(ks[l * 132 + c] * __expf(glast - sgc[l]));
    }
  }
}

DEV void gdn_scan_item(const P& p, int sitem, char* smem) {
  const int tid = otid(), lane = tid & 63, w = tid >> 6, r = lane & 31, h = lane >> 5;
  int stream, hd, half, nchunks, item0, row0, L;
  if (sitem < 8) { stream = 0; hd = sitem >> 1; half = sitem & 1; nchunks = 256; item0 = hd; row0 = 0; L = 64; }
  else { const int n = sitem - 8; const int b = n >> 3; hd = (n >> 1) & 3; half = n & 1; stream = 1 + b; nchunks = 1; item0 = (256 + b) * 4 + hd; row0 = TP + 16 * b; L = 16; }
  __syncthreads();
  if (w >= 2) {
    const unsigned lo = (unsigned)(tid - 128) * 16u;
    u32x4 ra[28], rb[28];
#define GS_LOAD(REG, C) { const char* img_ = p.ws + O_GIMG + (size_t)(item0 + (C) * 4) * GIMG_BYTES; _Pragma("unroll") for (int i = 0; i < 28; ++i) REG[i] = *(const u32x4*)((img_ + 2048 * i) + lo); }
#define GS_STORE(REG) { _Pragma("unroll") for (int i = 0; i < 28; ++i) *(u32x4*)(smem + 2048 * i + lo) = REG[i]; }
    GS_LOAD(ra, 0)
    if (nchunks > 1) GS_LOAD(rb, 1)
    for (int c = 0; c < nchunks; c += 2) {
      LBAR();
      GS_STORE(ra)
      LBAR();
      if (c + 2 < nchunks) GS_LOAD(ra, c + 2)
      if (c + 1 < nchunks) {
        LBAR();
        GS_STORE(rb)
        LBAR();
        if (c + 3 < nchunks) GS_LOAD(rb, c + 3)
      }
    }
  } else {
    const int vs = 2 * half + w;
    f32x16 S[4];
#pragma unroll
    for (int kt = 0; kt < 4; ++kt)
#pragma unroll
      for (int i = 0; i < 16; ++i) {
        float v = 0.f;
        if (stream > 0) v = p.in[5][(((size_t)(stream - 1) * 4 + hd) * 128 + 32 * kt + crow(i, h)) * 128 + 32 * vs + r];
        S[kt][i] = v;
      }
    const float* gl = (const float*)(p.ws + O_GL);
    float* oraw = (float*)(p.ws + O_ORAW);
    const unsigned uoff = (unsigned)(vs * 128 + lane) * 32u;
    u32x4 pu[4]; float gln;
    int a1[8], a2[4];
#pragma unroll
    for (int q = 0; q < 8; ++q) a1[q] = r * 256 + (((2 * q + h) ^ (r & 15)) << 4);
#pragma unroll
    for (int q = 0; q < 4; ++q) a2[q] = 32768 + r * 128 + (((2 * q + h) ^ ((r >> 1) & 7)) << 4);
    {
      const char* img = p.ws + O_GIMG + (size_t)item0 * GIMG_BYTES;
      gln = gl[item0];
#pragma unroll
      for (int mt = 0; mt < 2; ++mt) { pu[2 * mt] = *(const u32x4*)((img + 57344 + mt * 2048) + uoff); pu[2 * mt + 1] = *(const u32x4*)((img + 57344 + mt * 2048 + 16) + uoff); }
    }
    for (int c = 0; c < nchunks; ++c) {
      const int item = item0 + c * 4;
      LBAR();
      f32x16 U[2], O[2];
#pragma unroll
      for (int mt = 0; mt < 2; ++mt) {
#pragma unroll
        for (int e = 0; e < 4; ++e) { U[mt][2 * e] = bflo(pu[2 * mt][e]); U[mt][2 * e + 1] = bfhi(pu[2 * mt][e]); U[mt][8 + 2 * e] = bflo(pu[2 * mt + 1][e]); U[mt][8 + 2 * e + 1] = bfhi(pu[2 * mt + 1][e]); }
#pragma unroll
        for (int i = 0; i < 16; ++i) O[mt][i] = 0.f;
      }
      const float gamma = __expf(gln);
      if (c + 1 < nchunks) {
        const char* img = p.ws + O_GIMG + (size_t)(item + 4) * GIMG_BYTES;
        gln = gl[item + 4];
#pragma unroll
        for (int mt = 0; mt < 2; ++mt) { pu[2 * mt] = *(const u32x4*)((img + 57344 + mt * 2048) + uoff); pu[2 * mt + 1] = *(const u32x4*)((img + 57344 + mt * 2048 + 16) + uoff); }
      }
      LBAR();
      bf16x8 FA[8], FB[8];
#define LD1(F, KT) { _Pragma("unroll") for (int s_ = 0; s_ < 2; ++s_) { const char* b_ = smem + a1[2 * (KT) + s_]; \
        F[4 * s_ + 0] = *(const bf16x8*)(b_); F[4 * s_ + 1] = *(const bf16x8*)(b_ + 16384); F[4 * s_ + 2] = *(const bf16x8*)(b_ + 8192); F[4 * s_ + 3] = *(const bf16x8*)(b_ + 8192 + 16384); } }
#define MM1(F, KT) { _Pragma("unroll") for (int s_ = 0; s_ < 2; ++s_) { const bf16x8 sf_ = pack8(S[KT], s_); \
        U[0] = MFMA32(F[4 * s_ + 0], sf_, U[0]); O[0] = MFMA32(F[4 * s_ + 1], sf_, O[0]); U[1] = MFMA32(F[4 * s_ + 2], sf_, U[1]); O[1] = MFMA32(F[4 * s_ + 3], sf_, O[1]); } }
#define LD2(F) { _Pragma("unroll") for (int q_ = 0; q_ < 4; ++q_) { const char* b_ = smem + a2[q_]; F[2 * q_] = *(const bf16x8*)(b_); F[2 * q_ + 1] = *(const bf16x8*)(b_ + 4096); } }
#define LD3(F, M2) { _Pragma("unroll") for (int s_ = 0; s_ < 2; ++s_) { const char* b_ = smem + 8192 + a2[2 * (M2) + s_]; _Pragma("unroll") for (int kt_ = 0; kt_ < 4; ++kt_) F[4 * s_ + kt_] = *(const bf16x8*)(b_ + 4096 * kt_); } }
#define MM3(F, M2) { _Pragma("unroll") for (int s_ = 0; s_ < 2; ++s_) { _Pragma("unroll") for (int kt_ = 0; kt_ < 4; ++kt_) S[kt_] = MFMA32(F[4 * s_ + kt_], uf[M2][s_], S[kt_]); } }
#define SB __builtin_amdgcn_sched_barrier(0);
      LD1(FA, 0) SB
      LD1(FB, 1) SB MM1(FA, 0) SB
      LD1(FA, 2) SB MM1(FB, 1) SB
      LD1(FB, 3) SB MM1(FA, 2) SB
      LD2(FA) SB MM1(FB, 3) SB
      bf16x8 uf[2][2];
#pragma unroll
      for (int mt = 0; mt < 2; ++mt)
#pragma unroll
        for (int s = 0; s < 2; ++s) uf[mt][s] = pack8(U[mt], s);
      LD3(FB, 0) SB
#pragma unroll
      for (int q = 0; q < 4; ++q) { O[0] = MFMA32(FA[2 * q], uf[q >> 1][q & 1], O[0]); O[1] = MFMA32(FA[2 * q + 1], uf[q >> 1][q & 1], O[1]); }
#pragma unroll
      for (int kt = 0; kt < 4; ++kt)
#pragma unroll
        for (int i = 0; i < 16; ++i) S[kt][i] *= gamma;
      SB
      LD3(FA, 1) SB MM3(FB, 0) SB
      MM3(FA, 1) SB
      const int rbase = row0 + c * 64;
#pragma unroll
      for (int mt = 0; mt < 2; ++mt)
#pragma unroll
        for (int i = 0; i < 16; ++i) {
          const int rr = 32 * mt + crow(i, h);
          if (rr < L) oraw[(size_t)(rbase + rr) * 512 + hd * 128 + 32 * vs + r] = O[mt][i];
        }
    }
    float* dout = p.out + OUT_DELTA + ((size_t)stream * 4 + hd) * 128 * 128;
#pragma unroll
    for (int kt = 0; kt < 4; ++kt)
#pragma unroll
      for (int i = 0; i < 16; ++i) dout[(size_t)(32 * kt + crow(i, h)) * 128 + 32 * vs + r] = S[kt][i];
  }
}

DEV void fox_attn_item(const P& p, int aitem, char* smem) {
  const int tid = otid(), lane = tid & 63, w = tid >> 6, r = lane & 31, h = lane >> 5;
  int hd, b = 0, qrow0, nq, nkeys, qpos0, ntiles; bool dec;
  if (aitem < 32) { dec = true; b = aitem >> 2; hd = aitem & 3; qrow0 = TP + 16 * b; nq = 16; nkeys = 4112; qpos0 = 4096; ntiles = 129; }
  else { const int n = aitem - 32; dec = false; hd = n & 3; const int qb = 127 - (n >> 2); qrow0 = 128 * qb; nq = 128; nkeys = TP; qpos0 = qrow0; ntiles = ((qrow0 + 127) >> 5) + 1; }
  char* sK = smem; char* sV = smem + 8192;
  float* sck = (float*)(smem + 16384);
  float* sbase = (float*)(smem + 16640);
  float* sred = (float*)(smem + 16640 + 4352 * 4);
  const float* fk = p.out + OUT_FK; const float* fv = p.out + OUT_FV;
  const float* cl = (const float*)(p.ws + O_CL);
  __syncthreads();
  if (!dec) {
    if (tid == 0) { const float* tot = (const float*)(p.ws + O_TOT); float run = 0.f; for (int t = 0; t < 128; ++t) { sbase[t] = run; run += tot[t * 4 + hd]; } sbase[128] = run; }
  } else {
    float run = 0.f;
#pragma unroll 1
    for (int e = 0; e < 17; ++e) {
      const int j = tid * 17 + e; float v = 0.f;
      if (j < 4096) v = p.in[8][((size_t)b * 4096 + j) * 4 + hd];
      else if (j < 4112) v = p.out[OUT_LOGF + (size_t)(TP + 16 * b + (j - 4096)) * 4 + hd];
      run += v; sbase[j] = run;
    }
    sred[tid] = run;
    __syncthreads();
    if (tid == 0) { float a = 0.f; for (int t = 0; t < 256; ++t) { const float x = sred[t]; sred[t] = a; a += x; } }
    __syncthreads();
    const float basev = sred[tid];
#pragma unroll 1
    for (int e = 0; e < 17; ++e) sbase[tid * 17 + e] += basev;
  }
  __syncthreads();
  int kt_lo = 0;
  {
    const float thr = ((const float*)(p.ws + O_CTR))[40];
    if (!dec) {
      const float ci0 = sbase[qrow0 >> 7] + cl[(size_t)qrow0 * 4 + hd];
      int tb = 0;
      while (tb < (qrow0 >> 7) && ci0 - sbase[tb + 1] < -thr) ++tb;
      kt_lo = 4 * tb;
    } else {
      const float ci0 = sbase[4096];
      while (kt_lo < 128 && ci0 - sbase[32 * kt_lo + 31] < -thr) ++kt_lo;
    }
  }
  const bool active = 32 * w < nq;
  const int qi = 32 * w + r;
  const bool qvalid = qi < nq;
  const int qrow = qrow0 + (qvalid ? qi : 0);
  const int qpos = qpos0 + qi;
  float cq;
  if (!dec) cq = sbase[qpos >> 7] + cl[(size_t)qpos * 4 + hd]; else cq = sbase[qvalid ? qpos : 4096];
  cq *= LOG2E;
  bf16x8 qf[8];
  {
    const bf16_t* qp = (const bf16_t*)(p.ws + O_PROJ) + (size_t)qrow * NPROJ + 2048 + hd * 128 + 8 * h;
#pragma unroll
    for (int ks = 0; ks < 8; ++ks) qf[ks] = *(const bf16x8*)(qp + 16 * ks);
  }
  f32x16 O[4];
#pragma unroll
  for (int dt = 0; dt < 4; ++dt)
#pragma unroll
    for (int i = 0; i < 16; ++i) O[dt][i] = 0.f;
  float m = -1e30f, lsum = 0.f;
  const int kkl = tid >> 3, ksub = tid & 7;
  const int vkl = tid & 31, vdg = tid >> 5;
  f32x4 kreg[4], vreg[4]; float ckreg = 0.f;
  auto krow_ptr = [&](const float* base_out, const float* cache, int j) -> const float* {
    j = j < nkeys ? j : nkeys - 1;
    const float* p_new = base_out + ((size_t)(dec ? TP + 16 * b + (j - 4096) : j) * 4 + hd) * 128;
    const float* p_old = cache + (((size_t)b * 4096 + (j < 4096 ? j : 0)) * 4 + hd) * 128;
    return (dec && j < 4096) ? p_old : p_new;
  };
  auto gload = [&](int kt) {
    const float* kp = krow_ptr(fk, p.in[6], kt * 32 + kkl);
    const float* vp = krow_ptr(fv, p.in[7], kt * 32 + vkl);
#pragma unroll
    for (int e = 0; e < 4; ++e) {
      kreg[e] = *(const f32x4*)(kp + 16 * ksub + 4 * e);
      vreg[e] = *(const f32x4*)(vp + 16 * vdg + 4 * e);
    }
    if (tid < 32) {
      const int j = kt * 32 + tid;
      float c = 0.f;
      if (j < nkeys) c = dec ? sbase[j] : sbase[j >> 7] + cl[(size_t)j * 4 + hd];
      ckreg = c * LOG2E;
    }
  };
  gload(kt_lo);
  for (int kt = kt_lo; kt < ntiles; ++kt) {
    __syncthreads();
#pragma unroll
    for (int e = 0; e < 2; ++e) {
      const int cidx = ksub * 2 + e;
      u32x4 o; o[0] = pk2(kreg[2 * e][0], kreg[2 * e][1]); o[1] = pk2(kreg[2 * e][2], kreg[2 * e][3]);
      o[2] = pk2(kreg[2 * e + 1][0], kreg[2 * e + 1][1]); o[3] = pk2(kreg[2 * e + 1][2], kreg[2 * e + 1][3]);
      *(u32x4*)(sK + kkl * 256 + ((cidx ^ (kkl & 15)) << 4)) = o;
    }
    {
      const int pos = (vkl & ~15) + perm16(vkl & 15);
#pragma unroll
      for (int e = 0; e < 4; ++e)
#pragma unroll
        for (int f = 0; f < 4; ++f) {
          const int d = 16 * vdg + 4 * e + f;
          *(bf16_t*)(sV + d * 64 + (((pos >> 3) ^ ((d >> 2) & 3)) << 4) + (pos & 7) * 2) = f2bf(vreg[e][f]);
        }
    }
    if (tid < 32) sck[tid] = ckreg;
    __syncthreads();
    if (kt + 1 < ntiles) gload(kt + 1);
    if (active && (kt * 32 <= qpos0 + 32 * w + 31)) {
      f32x16 S;
#pragma unroll
      for (int i = 0; i < 16; ++i) S[i] = 0.f;
#pragma unroll
      for (int ks = 0; ks < 8; ++ks) {
        const bf16x8 a = *(const bf16x8*)(sK + r * 256 + (((2 * ks + h) ^ (r & 15)) << 4));
        S = MFMA32(a, qf[ks], S);
      }
      __builtin_amdgcn_sched_barrier(0);
      float mx = -INFINITY;
#pragma unroll
      for (int g = 0; g < 4; ++g) {
        const f32x4 ck4 = *(const f32x4*)(sck + 8 * g + 4 * h);
#pragma unroll
        for (int e = 0; e < 4; ++e) {
          const int i = 4 * g + e;
          const int kabs = kt * 32 + 8 * g + 4 * h + e;
          float sv = S[i] + (cq - ck4[e]);
          sv = (kabs <= qpos) ? sv : -INFINITY;
          S[i] = sv; mx = fmaxf(mx, sv);
        }
      }
      mx = fmaxf(mx, __shfl_xor(mx, 32));
      const float mn = fmaxf(m, mx);
      const float alpha = __builtin_amdgcn_exp2f(m - mn);
      m = mn;
      float ps = 0.f;
#pragma unroll
      for (int i = 0; i < 16; ++i) { const float pv = __builtin_amdgcn_exp2f(S[i] - mn); S[i] = pv; ps += pv; }
      lsum = lsum * alpha + ps;
#pragma unroll
      for (int dt = 0; dt < 4; ++dt)
#pragma unroll
        for (int i = 0; i < 16; ++i) O[dt][i] *= alpha;
      bf16x8 pf[2];
#pragma unroll
      for (int s = 0; s < 2; ++s) pf[s] = pack8(S, s);
      __builtin_amdgcn_sched_barrier(0);
#pragma unroll
      for (int dt = 0; dt < 4; ++dt)
#pragma unroll
        for (int s = 0; s < 2; ++s) {
          const int d = 32 * dt + r;
          const bf16x8 a = *(const bf16x8*)(sV + d * 64 + (((2 * s + h) ^ ((d >> 2) & 3)) << 4));
          O[dt] = MFMA32(a, pf[s], O[dt]);
        }
    }
  }
  if (active) {
    const float lt = lsum + __shfl_xor(lsum, 32);
    const float inv = 1.f / lt;
    if (qvalid) {
      bf16_t* op = (bf16_t*)(p.ws + O_R1) + (size_t)qrow * D + 512 + hd * 128;
#pragma unroll
      for (int dt = 0; dt < 4; ++dt)
#pragma unroll
        for (int g = 0; g < 4; ++g) {
          u32x2 o; o[0] = pk2(O[dt][4 * g] * inv, O[dt][4 * g + 1] * inv); o[1] = pk2(O[dt][4 * g + 2] * inv, O[dt][4 * g + 3] * inv);
          *(u32x2*)(op + 32 * dt + 8 * g + 4 * h) = o;
        }
    }
  }
}

DEV void wkv_scan_item(const P& p, int item, char* smem) {
  const int tid = otid(), lane = tid & 63, w = tid >> 6;
  int stream, hd, rg, row0, nsteps;
  if (item < 256) { stream = 0; hd = item >> 4; rg = item & 15; row0 = 0; nsteps = TP; }
  else { const int n = item - 256; const int b = n >> 8; stream = 1 + b; hd = (n >> 4) & 15; rg = n & 15; row0 = TP + 16 * b; nsteps = 16; }
  constexpr int BUF = 6 * 1024 + 16 * 8;
  float* bufs = (float*)smem;
  const bf16_t* rkv = (const bf16_t*)(p.ws + O_RKVB);
  const float* dec = (const float*)(p.ws + O_DEC);
  const bf16_t* ab = (const bf16_t*)(p.ws + O_AB);
  bf16_t* yraw = (bf16_t*)(p.ws + O_R1);
  const int nch = nsteps >> 4;
  __syncthreads();
  if (w > 0) {
    const int slot0 = tid - 64;
    const bool two = slot0 < 64;
    u32x2 rr_[4][2], kr_[4][2], vr_[4][2], ar_[4][2], kn_[4][2]; f32x4 dr_[4][2];
#define WKV_GLOAD(SET, C) { if ((C) < nch) { _Pragma("unroll") for (int q = 0; q < 2; ++q) { if (q == 1 && !two) break; \
        const int slot = slot0 + 192 * q; const int ltok = slot >> 4, ch = hd * 64 + (slot & 15) * 4; const size_t row = row0 + (C) * 16 + ltok; \
        rr_[SET][q] = *(const u32x2*)(rkv + row * 3072 + ch); kr_[SET][q] = *(const u32x2*)(rkv + row * 3072 + 1024 + ch); vr_[SET][q] = *(const u32x2*)(rkv + row * 3072 + 2048 + ch); \
        kn_[SET][q] = *(const u32x2*)(rkv + (row + 1) * 3072 + 1024 + ch); \
        ar_[SET][q] = *(const u32x2*)(ab + row * 1024 + ch); dr_[SET][q] = *(const f32x4*)(dec + row * 1024 + ch); } } }
#define WKV_PREP(SET, BI) { float* bp = bufs + (BI) * BUF; _Pragma("unroll") for (int q = 0; q < 2; ++q) { if (q == 1 && !two) break; \
        const int slot = slot0 + 192 * q; const int ltok = slot >> 4, lc4 = (slot & 15) * 4, ch = hd * 64 + lc4; \
        const f32x4 kkw = *(const f32x4*)(p.in[42] + ch), kaw = *(const f32x4*)(p.in[43] + ch); \
        const f32x4 r4 = {bflo(rr_[SET][q][0]), bfhi(rr_[SET][q][0]), bflo(rr_[SET][q][1]), bfhi(rr_[SET][q][1])}; \
        const f32x4 k4 = {bflo(kr_[SET][q][0]), bfhi(kr_[SET][q][0]), bflo(kr_[SET][q][1]), bfhi(kr_[SET][q][1])}; \
        const f32x4 v4 = {bflo(vr_[SET][q][0]), bfhi(vr_[SET][q][0]), bflo(vr_[SET][q][1]), bfhi(vr_[SET][q][1])}; \
        const f32x4 a4 = {bflo(ar_[SET][q][0]), bfhi(ar_[SET][q][0]), bflo(ar_[SET][q][1]), bfhi(ar_[SET][q][1])}; \
        const f32x4 n4 = {bflo(kn_[SET][q][0]), bfhi(kn_[SET][q][0]), bflo(kn_[SET][q][1]), bfhi(kn_[SET][q][1])}; \
        f32x4 kk4 = k4 * kkw; float ss = kk4[0] * kk4[0] + kk4[1] * kk4[1] + kk4[2] * kk4[2] + kk4[3] * kk4[3]; ss = row16_sum(ss); \
        const float rs = rsqrtf(ss + 1e-6f); kk4 = kk4 * rs; \
        f32x4 kn4 = n4 * kkw; float sn = kn4[0] * kn4[0] + kn4[1] * kn4[1] + kn4[2] * kn4[2] + kn4[3] * kn4[3]; sn = row16_sum(sn); \
        const float rn = rsqrtf(sn + 1e-6f); kn4 = kn4 * rn; \
        f32x4 kp4, b4, z4; float be = 0.f, ka_ = 0.f; \
        _Pragma("unroll") for (int e = 0; e < 4; ++e) { kp4[e] = k4[e] * (1.f + (a4[e] - 1.f) * kaw[e]); b4[e] = -kk4[e] * a4[e]; z4[e] = dr_[SET][q][e] * kn4[e]; be += b4[e] * kn4[e]; ka_ += kp4[e] * kn4[e]; } \
        be = row16_sum(be); ka_ = row16_sum(ka_); \
        *(f32x4*)(bp + 0 * 1024 + ltok * 64 + lc4) = r4; *(f32x4*)(bp + 1 * 1024 + ltok * 64 + lc4) = dr_[SET][q]; \
        *(f32x4*)(bp + 2 * 1024 + ltok * 64 + lc4) = kp4; *(f32x4*)(bp + 3 * 1024 + ltok * 64 + lc4) = kk4; *(f32x4*)(bp + 4 * 1024 + ltok * 64 + lc4) = b4; \
        *(f32x4*)(bp + 5 * 1024 + ltok * 64 + lc4) = z4; \
        if ((slot & 15) == rg) *(f32x4*)(bp + 6 * 1024 + ltok * 8) = v4; \
        if ((slot & 15) == 0) { f32x2 bk_ = {be, ka_}; *(f32x2*)(bp + 6 * 1024 + ltok * 8 + 4) = bk_; } } }
    WKV_GLOAD(0, 0) WKV_GLOAD(1, 1) WKV_GLOAD(2, 2) WKV_GLOAD(3, 3)
    WKV_PREP(0, 0)
    WKV_GLOAD(0, 4)
    LBAR();
    for (int c0 = 0; c0 < nch; c0 += 4) {
      { const int c = c0 + 0; if (c < nch) { if (c + 1 < nch) { WKV_PREP(1, 1) WKV_GLOAD(1, c + 5) } LBAR(); } }
      { const int c = c0 + 1; if (c < nch) { if (c + 1 < nch) { WKV_PREP(2, 0) WKV_GLOAD(2, c + 5) } LBAR(); } }
      { const int c = c0 + 2; if (c < nch) { if (c + 1 < nch) { WKV_PREP(3, 1) WKV_GLOAD(3, c + 5) } LBAR(); } }
      { const int c = c0 + 3; if (c < nch) { if (c + 1 < nch) { WKV_PREP(0, 0) WKV_GLOAD(0, c + 5) } LBAR(); } }
    }
  } else {
    const int rowl = lane >> 4, myrow = 4 * rg + rowl, c4 = (lane & 15) * 4;
    f32x4 st = {0.f, 0.f, 0.f, 0.f};
    if (stream > 0) st = *(const f32x4*)(p.in[10] + (((size_t)(stream - 1) * 16 + hd) * 64 + myrow) * 64 + c4);
    f32x2 slo = {st[0], st[1]}, shi = {st[2], st[3]};
    LBAR();
    float sa;
    { const f32x4 kk0 = *(const f32x4*)(bufs + 3 * 1024 + c4); sa = row16_sum(st[0] * kk0[0] + st[1] * kk0[1] + st[2] * kk0[2] + st[3] * kk0[3]); }
    for (int c = 0; c < nch; ++c) {
      const float* bp = bufs + (c & 1) * BUF;
      const float* bq = bp + c4;
      const float* bv = bp + 6 * 1024 + rowl;
      const float* bk = bp + 6 * 1024 + 4;
      float ykeep = 0.f, yprev = 0.f;
      f32x4 Z[16], W[16], NB[16], K[16], R[16]; float V[16]; f32x2 BK[16];
#define WLD(T) { Z[T] = *(const f32x4*)(bq + 5 * 1024 + (T) * 64); W[T] = *(const f32x4*)(bq + 1 * 1024 + (T) * 64); NB[T] = *(const f32x4*)(bq + 4 * 1024 + (T) * 64); \
        K[T] = *(const f32x4*)(bq + 2 * 1024 + (T) * 64); R[T] = *(const f32x4*)(bq + 0 * 1024 + (T) * 64); V[T] = bv[(T) * 8]; BK[T] = *(const f32x2*)(bk + (T) * 8); }
      WLD(0) WLD(1) WLD(2)
#pragma unroll
      for (int t = 0; t < 16; ++t) {
        if (t + 3 < 16) WLD(t + 3)
        __builtin_amdgcn_sched_barrier(0);
        const f32x4 z4 = Z[t], w4 = W[t], nb4 = NB[t], k4 = K[t], r4 = R[t]; const float vv = V[t]; const f32x2 bk2 = BK[t];
        const f32x2 zlo = {z4[0], z4[1]}, zhi = {z4[2], z4[3]}, wlo = {w4[0], w4[1]}, whi = {w4[2], w4[3]};
        const f32x2 nblo = {nb4[0], nb4[1]}, nbhi = {nb4[2], nb4[3]}, klo = {k4[0], k4[1]}, khi = {k4[2], k4[3]}, rlo = {r4[0], r4[1]}, rhi = {r4[2], r4[3]};
        f32x2 pp = slo * zlo; pp = shi * zhi + pp;
        float pr = pp[0] + pp[1];
        const f32x2 vklo = klo * vv, vkhi = khi * vv;
        const f32x2 tlo = nblo * sa + vklo, thi = nbhi * sa + vkhi;
        slo = slo * wlo + tlo; shi = shi * whi + thi;
        const float cnext = sa * bk2[0] + vv * bk2[1];
        pr = row16_sum(pr);
        if (t > 0) { const float yr = row16_sum(yprev); ykeep = ((lane & 15) == t - 1) ? yr : ykeep; }
        f32x2 qq = slo * rlo; qq = shi * rhi + qq;
        yprev = qq[0] + qq[1];
        sa = pr + cnext;
      }
      { const float yr = row16_sum(yprev); ykeep = ((lane & 15) == 15) ? yr : ykeep; }
      yraw[(size_t)(row0 + c * 16 + (lane & 15)) * 1024 + hd * 64 + myrow] = f2bf(ykeep);
      LBAR();
    }
    st = (f32x4){slo[0], slo[1], shi[0], shi[1]};
    *(f32x4*)(p.out + OUT_WKV + (((size_t)stream * 16 + hd) * 64 + myrow) * 64 + c4) = st;
  }
}

#define XB_TMO      128
#define XB_XCNT(j)  (256  + 64 * (j))
#define XB_XSUB(j)  (1280 + 64 * (j))
#define XB_XGEN(j)  (2304 + 64 * (j))
#define XB_TOP      3328
#define XB_TOPGEN   3392
#define XCD_BAR_WORDS 3456
#define XB_SPIN_CAP (1u << 20)
#define LAS3 __attribute__((address_space(3)))
DEV unsigned xb_ld(unsigned* p) { return __hip_atomic_load(p, __ATOMIC_RELAXED, __HIP_MEMORY_SCOPE_AGENT); }
DEV unsigned xb_add(unsigned* p, unsigned v) { return __hip_atomic_fetch_add(p, v, __ATOMIC_RELAXED, __HIP_MEMORY_SCOPE_AGENT); }
DEV unsigned xb_xcc_id() { return (unsigned)__builtin_amdgcn_s_getreg((3 << 11) | 20) & 0xFu; }
#define XB_SPIN(cond, bar) do { unsigned _sp = 0; while (cond) { __builtin_amdgcn_s_sleep(1); \
    if ((++_sp & 255u) == 0u) { if (xb_ld(&(bar)[XB_TMO])) break; if (_sp > XB_SPIN_CAP) { atomicAdd(&(bar)[XB_TMO], 1u); break; } } } } while (0)
struct XcdBarrier { unsigned* bar; unsigned x; volatile LAS3 unsigned* st; };
DEV XcdBarrier xcd_barrier_post(unsigned* bar, volatile LAS3 unsigned* st) {
  XcdBarrier b; b.bar = bar; b.x = xb_xcc_id(); b.st = st;
  if (threadIdx.x == 0) (void)xb_add(&bar[XB_XCNT(b.x)], 1u);
  return b;
}
DEV void xcd_barrier_complete(unsigned* bar, unsigned x, unsigned& nloc, unsigned& nx) {
  const unsigned G = gridDim.x;
  unsigned sum, cnt, mine, sp = 0u;
  for (;;) {
    sum = 0u; cnt = 0u; mine = 0u;
#pragma unroll
    for (unsigned j = 0; j < 16; ++j) { const unsigned c = xb_ld(&bar[XB_XCNT(j)]); sum += c; cnt += (c > 0u) ? 1u : 0u; mine = (j == x) ? c : mine; }
    if (sum == G) break;
    __builtin_amdgcn_s_sleep(1);
    if ((++sp & 255u) == 0u) { if (xb_ld(&bar[XB_TMO])) break; if (sp > XB_SPIN_CAP) { atomicAdd(&bar[XB_TMO], 1u); break; } }
  }
  nloc = mine > 0u ? mine : 1u; nx = cnt > 0u ? cnt : 1u;
}
DEV void xcd_barrier(const XcdBarrier& b) {
  asm volatile("s_waitcnt vmcnt(0)" ::: "memory");
  __syncthreads();
  if (threadIdx.x == 0) {
    unsigned* bar = b.bar;
    __builtin_amdgcn_s_waitcnt(0);
    unsigned nloc = b.st[0], nx = b.st[1];
    if (nloc == 0u) { xcd_barrier_complete(bar, b.x, nloc, nx); b.st[0] = nloc; b.st[1] = nx; }
    const unsigned old = xb_add(&bar[XB_XSUB(b.x)], 1u);
    const unsigned gen = old / nloc;
    if (old + 1u == (gen + 1u) * nloc) {
      __builtin_amdgcn_fence(__ATOMIC_RELEASE, "agent");
      asm volatile("s_waitcnt vmcnt(0)" ::: "memory");
      const unsigned og = xb_add(&bar[XB_TOP], 1u);
      const unsigned tg = og / nx;
      if (og + 1u == (tg + 1u) * nx) xb_add(&bar[XB_TOPGEN], 1u);
      else XB_SPIN(xb_ld(&bar[XB_TOPGEN]) == tg, bar);
      __builtin_amdgcn_fence(__ATOMIC_ACQUIRE, "agent");
      xb_add(&bar[XB_XGEN(b.x)], 1u);
      asm volatile("s_waitcnt vmcnt(0)" ::: "memory");
    } else {
      XB_SPIN(xb_ld(&bar[XB_XGEN(b.x)]) == gen, bar);
      __builtin_amdgcn_fence(__ATOMIC_ACQUIRE, "agent");
      asm volatile("s_waitcnt vmcnt(0)" ::: "memory");
    }
  }
  __syncthreads();
}

__global__ void __launch_bounds__(NTHREADS, 2) mega(P p) {
  cg::grid_group grid = cg::this_grid();
  __shared__ __attribute__((aligned(16))) char smem[SMEM_BYTES];
  __shared__ int s_item;
  __shared__ __attribute__((aligned(16))) unsigned xb_st[4];
  const int tid = otid(), lane = tid & 63, wid = tid >> 6;
  const int G = gridDim.x, bid = blockIdx.x;
  char* ws = p.ws;
  const float* mod0 = (const float*)(ws + O_MOD);
  const float* mod1 = mod0 + 9 * 6144;
  float* xbuf = p.out + OUT_Y;
  bf16_t* R1 = (bf16_t*)(ws + O_R1);
  unsigned* bar = (unsigned*)(ws + O_BAR);
  if (threadIdx.x < 4) xb_st[threadIdx.x] = 0u;
  __syncthreads();
  const XcdBarrier xb = xcd_barrier_post(bar, (volatile LAS3 unsigned*)xb_st);

  phase0(p, smem);
  grid.sync();
  rownorm_phase(p, nullptr, p.in[13], 0, 0, 1, R1, 0);
  xcd_barrier(xb);
  {
    bf16_t* proj = (bf16_t*)(ws + O_PROJ); float* pab = (float*)(ws + O_PAB); float* conv = p.out + OUT_CONV;
    auto epi = [&](int row, int col, const f32x4& v, const PV& pv) {
      if (col < NPROJ) {
        st_bf4(proj + (size_t)row * NPROJ + col, v);
        if (col < 1536) {
          if (row >= TP - 3 && row < TP) *(f32x4*)(conv + (size_t)(row - (TP - 3)) * 1536 + col) = v;
          else if (row >= TP && ((row - TP) & 15) >= 13) *(f32x4*)(conv + ((size_t)(1 + ((row - TP) >> 4)) * 3 + (((row - TP) & 15) - 13)) * 1536 + col) = v;
        }
      } else if (col < NPROJ + 12) *(f32x4*)(pab + (size_t)row * 16 + (col - NPROJ)) = v;
    };
    for (int t = bid; t < 128 * 15 + 58; t += G) {
      if (t < 128 * 15) {
        const int mt = t / 15, j = t % 15;
        if (j < 14) gemm_tile<0, 256>(R1, D, (const bf16_t*)(ws + O_WIN), D, D, mt * 128, j * 256, smem, nullptr, epi);
        else gemm_tile<0, 128>(R1, D, (const bf16_t*)(ws + O_WIN), D, D, mt * 128, 3584, smem, nullptr, epi);
      } else gemm_tile<0, 64>(R1, D, (const bf16_t*)(ws + O_WIN), D, D, 128 * 128, (t - 128 * 15) * 64, smem, nullptr, epi);
    }
  }
  xcd_barrier(xb);
  for (int t = bid; t < 129 + GITEMS; t += G) {
#if PM & 4
    if (t < GITEMS) gdn_prep_item(p, t, smem); else fox_prep_tile(p, t - GITEMS, smem);
#endif
  }
  xcd_barrier(xb);
  {
  #if PM & 1
    if (bid < 72) gdn_scan_item(p, bid, smem);
#endif
    unsigned* ctr = (unsigned*)(ws + O_CTR);
    for (;;) {
      __syncthreads();
      if (tid == 0) s_item = (int)atomicAdd(ctr, 1u);
      __syncthreads();
      const int it = s_item;
      if (it >= 32 + 512) break;
#if PM & 2
      fox_attn_item(p, it, smem);
#endif
    }
  }
  xcd_barrier(xb);
  {
    const float* oraw = (const float*)(ws + O_ORAW); const bf16_t* proj = (const bf16_t*)(ws + O_PROJ); const float* on = p.in[19];
    for (int row = bid * 4 + wid; row < T; row += G * 4) {
#pragma unroll
      for (int hd = 0; hd < 4; ++hd) {
        const int c = hd * 128 + lane * 2;
        const f32x2 o = *(const f32x2*)(oraw + (size_t)row * 512 + c);
        const float ss = wave_sum(o[0] * o[0] + o[1] * o[1]); const float rs = rsqrtf(ss * (1.f / 128.f) + 1e-6f);
        const unsigned zu = *(const unsigned*)(proj + (size_t)row * NPROJ + 1536 + c);
        *(unsigned*)(R1 + (size_t)row * D + c) = pk2(o[0] * rs * on[lane * 2] * siluf_(bflo(zu)), o[1] * rs * on[lane * 2 + 1] * siluf_(bfhi(zu)));
      }
    }
  }
  xcd_barrier(xb);
  {
    auto pre = [&](int row, int col) { PV o; o.a = *(const f32x4*)(xin_row(p, row) + col); o.b = *(const f32x4*)(mod0 + stream_of(row) * 6144 + 2 * 1024 + col); return o; };
    auto epi = [&](int row, int col, const f32x4& v, const PV& pv) { *(f32x4*)(xbuf + (size_t)row * D + col) = pv.a + pv.b * v; };
    for (int t = bid; t < 512 + 16; t += G) {
      if (t < 512) gemm_tile<0, 256>(R1, D, (const bf16_t*)(ws + O_WOUT), D, D, (t >> 2) * 128, (t & 3) * 256, smem, nullptr, epi, pre);
      else gemm_tile<0, 64>(R1, D, (const bf16_t*)(ws + O_WOUT), D, D, 128 * 128, (t - 512) * 64, smem, nullptr, epi, pre);
    }
  }
  xcd_barrier(xb);
  rownorm_phase(p, xbuf, p.in[14], 0, 3, 4, R1, 0);
  xcd_barrier(xb);
  {
    bf16_t* hid = (bf16_t*)(ws + O_HID);
    auto epi = [&](int row, int col, const f32x4& v, const PV& pv) { f32x4 o; for (int e = 0; e < 4; ++e) { const float rl = fmaxf(v[e], 0.f); o[e] = rl * rl; } st_bf4(hid + (size_t)row * DFF + col, o); };
    for (int t = bid; t < 2048 + 64; t += G) {
      if (t < 2048) gemm_tile<0, 256>(R1, D, (const bf16_t*)(ws + O_FF1_0), D, D, (t >> 4) * 128, (t & 15) * 256, smem, nullptr, epi);
      else gemm_tile<0, 64>(R1, D, (const bf16_t*)(ws + O_FF1_0), D, D, 128 * 128, (t - 2048) * 64, smem, nullptr, epi);
    }
  }
  xcd_barrier(xb);
  {
    auto pre = [&](int row, int col) { PV o; o.a = *(const f32x4*)(xbuf + (size_t)row * D + col); o.b = *(const f32x4*)(mod0 + stream_of(row) * 6144 + 5 * 1024 + col); return o; };
    auto epi = [&](int row, int col, const f32x4& v, const PV& pv) { *(f32x4*)(xbuf + (size_t)row * D + col) = pv.a + pv.b * v; };
    for (int t = bid; t < 512 + 16; t += G) {
      if (t < 512) gemm_tile<0, 256>((const bf16_t*)(ws + O_HID), DFF, (const bf16_t*)(ws + O_FF2_0), DFF, DFF, (t >> 2) * 128, (t & 3) * 256, smem, nullptr, epi, pre);
      else gemm_tile<0, 64>((const bf16_t*)(ws + O_HID), DFF, (const bf16_t*)(ws + O_FF2_0), DFF, DFF, 128 * 128, (t - 512) * 64, smem, nullptr, epi, pre);
    }
  }
  xcd_barrier(xb);
  rownorm_phase(p, xbuf, p.in[28], 1, 0, 1, R1, 1);
  xcd_barrier(xb);
  {
    bf16_t* rkvb = (bf16_t*)(ws + O_RKVB); bf16_t* lw = (bf16_t*)(ws + O_LW); bf16_t* la = (bf16_t*)(ws + O_LA); bf16_t* lg = (bf16_t*)(ws + O_LG);
    auto epi_rkv = [&](int row, int col, const f32x4& v, const PV& pv) { st_bf4(rkvb + (size_t)row * 3072 + col, v); };
    for (int t = bid; t < 128 * 16 + 56; t += G) {
      int m0, n0, kind;
      if (t < 128 * 16) { const int j = t & 15; m0 = (t >> 4) * 128; if (j < 12) { n0 = j * 256; kind = 0; } else { n0 = 3072 + (j - 12) * 128; kind = 1; } }
      else { m0 = 128 * 128; n0 = (t - 128 * 16) * 64; kind = 2; }
      if (n0 < 3072) {
        const int g = n0 >> 10; const int mui = g == 0 ? 0 : (g == 1 ? 2 : 3);
        if (kind == 0) gemm_tile<1, 256>(R1, D, (const bf16_t*)(ws + O_RKV), D, D, m0, n0, smem, p.in[30] + mui * 1024, epi_rkv);
        else gemm_tile<1, 64>(R1, D, (const bf16_t*)(ws + O_RKV), D, D, m0, n0, smem, p.in[30] + mui * 1024, epi_rkv);
      } else {
        const int nt = 24 + ((n0 - 3072) >> 7);
        const int mui = nt == 24 ? 1 : (nt == 25 ? 4 : 5);
        auto epi = [&](int row, int col, const f32x4& v, const PV& pv) {
          if (nt == 24) { if (col < 64) { const f32x4 o = {tanhf(v[0]), tanhf(v[1]), tanhf(v[2]), tanhf(v[3])}; st_bf4(lw + (size_t)row * 64 + col, o); } }
          else if (nt == 25) { const int c = col - 128; if (c < 64) st_bf4(la + (size_t)row * 64 + c, v); }
          else { const int c = col - 256; if (c < 192) { f32x4 o = {0.f, 0.f, 0.f, 0.f}; if (c < 160) o = (f32x4){sigmoidf_(v[0]), sigmoidf_(v[1]), sigmoidf_(v[2]), sigmoidf_(v[3])}; st_bf4(lg + (size_t)row * 192 + c, o); } }
        };
        if (kind == 1) gemm_tile<1, 128>(R1, D, (const bf16_t*)(ws + O_LORA1), D, D, m0, n0 - 3072, smem, p.in[30] + mui * 1024, epi);
        else gemm_tile<1, 64>(R1, D, (const bf16_t*)(ws + O_LORA1), D, D, m0, n0 - 3072, smem, p.in[30] + mui * 1024, epi);
      }
    }
  }
  xcd_barrier(xb);
  {
    float* dec = (float*)(ws + O_DEC); bf16_t* abuf = (bf16_t*)(ws + O_AB); bf16_t* gate = (bf16_t*)(ws + O_GATE);
    const float* w0 = p.in[34]; const float* a0 = p.in[37];
    for (int t = bid; t < 129 * 24; t += G) {
      const int mt = t / 24, nt = t % 24, g = nt >> 3, n0 = (nt & 7) * 128;
      if (g == 0) {
        auto pre = [&](int row, int col) { PV o; o.a = *(const f32x4*)(w0 + col); o.b = o.a; return o; };
        auto epi = [&](int row, int col, const f32x4& v, const PV& pv) { f32x4 o; for (int e = 0; e < 4; ++e) { const float wl = -softplusf_(-(pv.a[e] + v[e])) - 0.5f; o[e] = __expf(-__expf(wl)); } *(f32x4*)(dec + (size_t)row * D + col) = o; };
        gemm_tile<0>((const bf16_t*)(ws + O_LW), 64, (const bf16_t*)(ws + O_W2), 64, 64, mt * 128, n0, smem, nullptr, epi, pre);
      } else if (g == 1) {
        auto pre = [&](int row, int col) { PV o; o.a = *(const f32x4*)(a0 + col); o.b = o.a; return o; };
        auto epi = [&](int row, int col, const f32x4& v, const PV& pv) { f32x4 o; for (int e = 0; e < 4; ++e) o[e] = sigmoidf_(pv.a[e] + v[e]); st_bf4(abuf + (size_t)row * D + col, o); };
        gemm_tile<0>((const bf16_t*)(ws + O_LA), 64, (const bf16_t*)(ws + O_A2), 64, 64, mt * 128, n0, smem, nullptr, epi, pre);
      } else {
        auto epi = [&](int row, int col, const f32x4& v, const PV& pv) { st_bf4(gate + (size_t)row * D + col, v); };
        gemm_tile<0>((const bf16_t*)(ws + O_LG), 192, (const bf16_t*)(ws + O_G2), 192, 192, mt * 128, n0, smem, nullptr, epi);
      }
    }
  }
  xcd_barrier(xb);
#if PM & 8
  if (G > 256) {
    if (bid < 256) wkv_scan_item(p, bid, smem);
    else for (int it = 256 + (bid - 256); it < 256 + 2048; it += G - 256) wkv_scan_item(p, it, smem);
  } else {
    for (int it = bid; it < 256 + 2048; it += G) wkv_scan_item(p, it, smem);
  }
#endif
  xcd_barrier(xb);
  {
    const bf16_t* yraw = R1; const bf16_t* rkvb = (const bf16_t*)(ws + O_RKVB); const bf16_t* abuf = (const bf16_t*)(ws + O_AB);
    const bf16_t* gate = (const bf16_t*)(ws + O_GATE); bf16_t* ybf = (bf16_t*)(ws + O_DEC);
    const float* ka = p.in[43]; const float* rk = p.in[44]; const float* lnw = p.in[45]; const float* lnb = p.in[46];
    for (int row = bid * 4 + wid; row < T; row += G * 4) {
      const int c0 = lane * 16;
      u32x4 yv[2], rv[2], kv[2], vv[2], av[2], gv[2];
#pragma unroll
      for (int q = 0; q < 2; ++q) {
        yv[q] = *(const u32x4*)(yraw + (size_t)row * D + c0 + 8 * q);
        rv[q] = *(const u32x4*)(rkvb + (size_t)row * 3072 + c0 + 8 * q);
        kv[q] = *(const u32x4*)(rkvb + (size_t)row * 3072 + 1024 + c0 + 8 * q);
        vv[q] = *(const u32x4*)(rkvb + (size_t)row * 3072 + 2048 + c0 + 8 * q);
        av[q] = *(const u32x4*)(abuf + (size_t)row * D + c0 + 8 * q);
        gv[q] = *(const u32x4*)(gate + (size_t)row * D + c0 + 8 * q);
      }
      float y[16]; float sum = 0.f, bs = 0.f;
#pragma unroll
      for (int e = 0; e < 16; ++e) {
        const unsigned yu = yv[e >> 3][(e >> 1) & 3], ru = rv[e >> 3][(e >> 1) & 3], ku = kv[e >> 3][(e >> 1) & 3], au = av[e >> 3][(e >> 1) & 3];
        const float yy = (e & 1) ? bfhi(yu) : bflo(yu), rr = (e & 1) ? bfhi(ru) : bflo(ru), kk = (e & 1) ? bfhi(ku) : bflo(ku), aa = (e & 1) ? bfhi(au) : bflo(au);
        y[e] = yy; sum += yy;
        const float kp = kk * (1.f + (aa - 1.f) * ka[c0 + e]);
        bs += rr * kp * rk[c0 + e];
      }
      sum = dpp_add(sum, 0); sum = dpp_add(sum, 1);
      bs = dpp_add(bs, 0); bs = dpp_add(bs, 1);
      const float mean = sum * (1.f / 64.f);
      float vs_ = 0.f;
#pragma unroll
      for (int e = 0; e < 16; ++e) { const float d = y[e] - mean; vs_ += d * d; }
      vs_ = dpp_add(vs_, 0); vs_ = dpp_add(vs_, 1);
      const float rstd = rsqrtf(vs_ * (1.f / 64.f) + 64e-5f);
      u32x4 ov[2];
#pragma unroll
      for (int e = 0; e < 16; e += 2) {
        float o2[2];
#pragma unroll
        for (int f = 0; f < 2; ++f) {
          const int ee = e + f;
          const unsigned vu = vv[ee >> 3][(ee >> 1) & 3], gu = gv[ee >> 3][(ee >> 1) & 3];
          const float vvv = (ee & 1) ? bfhi(vu) : bflo(vu), gg = (ee & 1) ? bfhi(gu) : bflo(gu);
          const float yn = (y[ee] - mean) * rstd * lnw[c0 + ee] + lnb[c0 + ee];
          o2[f] = (yn + bs * vvv) * gg;
        }
        ov[e >> 3][(e >> 1) & 3] = pk2(o2[0], o2[1]);
      }
      *(u32x4*)(ybf + (size_t)row * D + c0) = ov[0];
      *(u32x4*)(ybf + (size_t)row * D + c0 + 8) = ov[1];
    }
  }
  xcd_barrier(xb);
  {
    auto pre = [&](int row, int col) { PV o; o.a = *(const f32x4*)(xbuf + (size_t)row * D + col); o.b = *(const f32x4*)(mod1 + stream_of(row) * 6144 + 2 * 1024 + col); return o; };
    auto epi = [&](int row, int col, const f32x4& v, const PV& pv) { *(f32x4*)(xbuf + (size_t)row * D + col) = pv.a + pv.b * v; };
    for (int t = bid; t < 512 + 16; t += G) {
      if (t < 512) gemm_tile<0, 256>((const bf16_t*)(ws + O_DEC), D, (const bf16_t*)(ws + O_WO), D, D, (t >> 2) * 128, (t & 3) * 256, smem, nullptr, epi, pre);
      else gemm_tile<0, 64>((const bf16_t*)(ws + O_DEC), D, (const bf16_t*)(ws + O_WO), D, D, 128 * 128, (t - 512) * 64, smem, nullptr, epi, pre);
    }
  }
  xcd_barrier(xb);
  rownorm_phase(p, xbuf, p.in[29], 1, 3, 4, R1, 0);
  xcd_barrier(xb);
  {
    bf16_t* hid = (bf16_t*)(ws + O_HID);
    auto epi = [&](int row, int col, const f32x4& v, const PV& pv) { f32x4 o; for (int e = 0; e < 4; ++e) { const float rl = fmaxf(v[e], 0.f); o[e] = rl * rl; } st_bf4(hid + (size_t)row * DFF + col, o); };
    for (int t = bid; t < 2048 + 64; t += G) {
      if (t < 2048) gemm_tile<0, 256>(R1, D, (const bf16_t*)(ws + O_FF1_1), D, D, (t >> 4) * 128, (t & 15) * 256, smem, nullptr, epi);
      else gemm_tile<0, 64>(R1, D, (const bf16_t*)(ws + O_FF1_1), D, D, 128 * 128, (t - 2048) * 64, smem, nullptr, epi);
    }
  }
  xcd_barrier(xb);
  {
    auto pre = [&](int row, int col) { PV o; o.a = *(const f32x4*)(xbuf + (size_t)row * D + col); o.b = *(const f32x4*)(mod1 + stream_of(row) * 6144 + 5 * 1024 + col); return o; };
    auto epi = [&](int row, int col, const f32x4& v, const PV& pv) { *(f32x4*)(xbuf + (size_t)row * D + col) = pv.a + pv.b * v; };
    for (int t = bid; t < 512 + 16; t += G) {
      if (t < 512) gemm_tile<0, 256>((const bf16_t*)(ws + O_HID), DFF, (const bf16_t*)(ws + O_FF2_1), DFF, DFF, (t >> 2) * 128, (t & 3) * 256, smem, nullptr, epi, pre);
      else gemm_tile<0, 64>((const bf16_t*)(ws + O_HID), DFF, (const bf16_t*)(ws + O_FF2_1), DFF, DFF, 128 * 128, (t - 512) * 64, smem, nullptr, epi, pre);
    }
  }
}

extern "C" void kernel_launch(void* const* d_in, const int* in_sizes, int n_in, void* d_out, int out_size, void* d_ws, size_t ws_size,
                              hipStream_t stream) {
  static int grid_blocks = 0;
  if (!grid_blocks) {
    int dev = 0, cus = 0, per_cu = 0;
    hipGetDevice(&dev);
    hipDeviceGetAttribute(&cus, hipDeviceAttributeMultiprocessorCount, dev);
    hipOccupancyMaxActiveBlocksPerMultiprocessor(&per_cu, mega, NTHREADS, 0);
    if (per_cu > 2) per_cu = 2;
    grid_blocks = cus * per_cu;
    if (ws_size < WS_NEED) fprintf(stderr, "workspace too small: %zu < %zu\n", ws_size, (size_t)WS_NEED);
  }
  P p{};
  for (int i = 0; i < 50; ++i) p.in[i] = (const float*)d_in[i];
  p.out = (float*)d_out;
  p.ws = (char*)d_ws;
  (void)hipMemsetAsync((char*)d_ws + O_BAR, 0, 16384, stream);
  void* args[] = {&p};
  hipError_t e = hipLaunchCooperativeKernel((void*)mega, dim3(grid_blocks), dim3(NTHREADS), args, 0, stream);
  if (e != hipSuccess) fprintf(stderr, "cooperative launch failed: %s (grid %d)\n", hipGetErrorString(e), grid_blocks);
}
```

```cpp
#include <hip/hip_runtime.h>
#include <hip/hip_cooperative_groups.h>
#include <cstdio>
#include <cstdint>
namespace cg = cooperative_groups;
#ifndef PM
#define PM 255
#endif

#define DEV __device__ __forceinline__
typedef unsigned short bf16_t;
typedef short bf16x8 __attribute__((ext_vector_type(8)));
typedef float f32x2 __attribute__((ext_vector_type(2)));
typedef float f32x4 __attribute__((ext_vector_type(4)));
typedef float f32x16 __attribute__((ext_vector_type(16)));
typedef unsigned u32x2 __attribute__((ext_vector_type(2)));
typedef unsigned u32x4 __attribute__((ext_vector_type(4)));
typedef __bf16 bf2_t __attribute__((ext_vector_type(2)));

constexpr int D = 1024, TP = 16384, TS = 128, T = TP + TS, NS = 9, DFF = 4096;
constexpr int NWIN = 3712;
constexpr int NPROJ = 3584;
constexpr float LOG2E = 1.4426950408889634f;
constexpr int NTHREADS = 256;
constexpr int SMEM_BYTES = 57344 + 1024;

constexpr size_t OUT_Y = 0;
constexpr size_t OUT_CONV = OUT_Y + (size_t)T * D;
constexpr size_t OUT_DELTA = OUT_CONV + 9ull * 3 * 1536;
constexpr size_t OUT_FK = OUT_DELTA + 9ull * 4 * 128 * 128;
constexpr size_t OUT_FV = OUT_FK + (size_t)T * 512;
constexpr size_t OUT_LOGF = OUT_FV + (size_t)T * 512;
constexpr size_t OUT_SHIFT = OUT_LOGF + (size_t)T * 4;
constexpr size_t OUT_WKV = OUT_SHIFT + 9ull * 1024;
constexpr size_t OUT_TOTAL = OUT_WKV + 9ull * 16 * 64 * 64;

constexpr size_t al256(size_t x) { return (x + 255) & ~(size_t)255; }
constexpr size_t O_WIN = 0;
constexpr size_t O_WOUT = O_WIN + (size_t)NWIN * 1024 * 2;
constexpr size_t O_FF1_0 = O_WOUT + 1024ull * 1024 * 2;
constexpr size_t O_FF2_0 = O_FF1_0 + 4096ull * 1024 * 2;
constexpr size_t O_RKV = O_FF2_0 + 4096ull * 1024 * 2;
constexpr size_t O_LORA1 = O_RKV + 3072ull * 1024 * 2;
constexpr size_t O_W2 = O_LORA1 + 512ull * 1024 * 2;
constexpr size_t O_A2 = O_W2 + 1024ull * 64 * 2;
constexpr size_t O_G2 = O_A2 + 1024ull * 64 * 2;
constexpr size_t O_WO = O_G2 + 1024ull * 192 * 2;
constexpr size_t O_FF1_1 = O_WO + 1024ull * 1024 * 2;
constexpr size_t O_FF2_1 = O_FF1_1 + 4096ull * 1024 * 2;
constexpr size_t O_MOD = O_FF2_1 + 4096ull * 1024 * 2;
constexpr size_t O_CTR = O_MOD + 2ull * 9 * 6144 * 4;
constexpr size_t O_TOT = O_CTR + 256;
constexpr size_t O_CL = al256(O_TOT + 129 * 16);
constexpr size_t O_PAB = al256(O_CL + (size_t)T * 16);
constexpr size_t O_GL = al256(O_PAB + (size_t)T * 64);
constexpr size_t O_BAR = al256(O_GL + 8192);
constexpr size_t O_R1 = al256(O_BAR + 16384);
constexpr size_t R1_BYTES = 34ull << 20;
constexpr size_t O_R2 = O_R1 + R1_BYTES;
constexpr size_t O_PROJ = O_R2;
constexpr size_t O_GIMG = al256(O_PROJ + (size_t)T * NPROJ * 2);
constexpr int GITEMS = 264 * 4;
constexpr size_t GIMG_BYTES = 73728;
constexpr size_t O_ORAW = al256(O_GIMG + (size_t)GITEMS * GIMG_BYTES);
constexpr size_t L0_END = O_ORAW + (size_t)T * 512 * 4;
constexpr size_t O_HID = O_R2;
constexpr size_t O_RKVB = O_R2;
constexpr size_t O_LW = al256(O_RKVB + (size_t)T * 3072 * 2);
constexpr size_t O_LA = al256(O_LW + (size_t)T * 64 * 2);
constexpr size_t O_LG = al256(O_LA + (size_t)T * 64 * 2);
constexpr size_t O_DEC = al256(O_LG + (size_t)T * 192 * 2);
constexpr size_t O_AB = al256(O_DEC + (size_t)T * 1024 * 4);
constexpr size_t O_GATE = al256(O_AB + (size_t)T * 1024 * 2);
constexpr size_t L1_END = O_GATE + (size_t)T * 1024 * 2;
constexpr size_t HID_END = O_HID + (size_t)T * 4096 * 2;
constexpr size_t WS_NEED = (L0_END > L1_END ? (L0_END > HID_END ? L0_END : HID_END) : (L1_END > HID_END ? L1_END : HID_END));

struct P { const float* in[50]; float* out; char* ws; };

DEV unsigned pk2(float a, float b) { f32x2 v = {a, b}; bf2_t r = __builtin_convertvector(v, bf2_t); return __builtin_bit_cast(unsigned, r); }
DEV bf16_t f2bf(float a) { return (bf16_t)(pk2(a, 0.f) & 0xffffu); }
DEV void st_bf4(bf16_t* p, const f32x4& v) { u32x2 o; o[0] = pk2(v[0], v[1]); o[1] = pk2(v[2], v[3]); *(u32x2*)p = o; }
DEV float bf2f(bf16_t b) { return __uint_as_float(((unsigned)b) << 16); }
DEV float bflo(unsigned u) { return __uint_as_float(u << 16); }
DEV float bfhi(unsigned u) { return __uint_as_float(u & 0xffff0000u); }
DEV int otid() { int t = threadIdx.x; asm volatile("" : "+v"(t)); return t; }
DEV float dpp_add(float x, const int ctrl_sel) {
  int xi = __float_as_int(x), yi;
  if (ctrl_sel == 0) yi = __builtin_amdgcn_update_dpp(0, xi, 0xB1, 0xF, 0xF, true);
  else if (ctrl_sel == 1) yi = __builtin_amdgcn_update_dpp(0, xi, 0x4E, 0xF, 0xF, true);
  else if (ctrl_sel == 2) yi = __builtin_amdgcn_update_dpp(0, xi, 0x141, 0xF, 0xF, true);
  else yi = __builtin_amdgcn_update_dpp(0, xi, 0x140, 0xF, 0xF, true);
  return x + __int_as_float(yi);
}
DEV float row16_sum(float x) { x = dpp_add(x, 0); x = dpp_add(x, 1); x = dpp_add(x, 2); x = dpp_add(x, 3); return x; }
DEV float wave_sum(float v) {
  v = row16_sum(v);
  const int vi = __float_as_int(v);
  const float a = __int_as_float(__builtin_amdgcn_readlane(vi, 0)), b = __int_as_float(__builtin_amdgcn_readlane(vi, 16));
  const float c = __int_as_float(__builtin_amdgcn_readlane(vi, 32)), d = __int_as_float(__builtin_amdgcn_readlane(vi, 48));
  return (a + b) + (c + d);
}
DEV float sigmoidf_(float x) { return 1.f / (1.f + __expf(-x)); }
DEV float siluf_(float x) { return x / (1.f + __expf(-x)); }
DEV float softplusf_(float x) { return x > 20.f ? x : log1pf(__expf(x)); }
DEV float logsigmoidf_(float x) { return fminf(x, 0.f) - log1pf(__expf(-fabsf(x))); }
DEV int stream_of(int row) { return row < TP ? 0 : 1 + ((row - TP) >> 4); }
DEV int perm16(int o) { return 8 * ((o >> 2) & 1) + (o & 3) + 4 * (o >> 3); }
DEV int crow(int i, int h) { return (i & 3) + 8 * (i >> 2) + 4 * h; }
DEV bf16x8 pack8(const f32x16& x, const int s) {
  u32x4 p;
  p[0] = pk2(x[8 * s + 0], x[8 * s + 1]); p[1] = pk2(x[8 * s + 2], x[8 * s + 3]);
  p[2] = pk2(x[8 * s + 4], x[8 * s + 5]); p[3] = pk2(x[8 * s + 6], x[8 * s + 7]);
  return __builtin_bit_cast(bf16x8, p);
}
#define LBAR() asm volatile("s_waitcnt lgkmcnt(0)\n\ts_barrier" ::: "memory")
#define MFMA32(a, b, c) __builtin_amdgcn_mfma_f32_32x32x16_bf16((a), (b), (c), 0, 0, 0)
DEV const float* xin_row(const P& p, int row) { return row < TP ? p.in[0] + (size_t)row * D : p.in[1] + (size_t)(row - TP) * D; }

constexpr int LDT = 144;

template <int MIX, int BN>
DEV void gemm_gload(const bf16_t* A, int lda, const bf16_t* B, int ldb, int m0, int n0, int k0, int tid,
                    u32x4 (&ra)[4], u32x4 (&rp)[4], f32x4 (&rm)[2], u32x4 (&rb)[BN / 32], const float* mu) {
  const int kc = tid & 7, r0 = tid >> 3;
#pragma unroll
  for (int i = 0; i < 4; ++i) {
    const int row = r0 + 32 * i;
    if (!MIX) {
      ra[i] = *(const u32x4*)(A + (size_t)(m0 + row) * lda + k0 + kc * 8);
    } else {
      const int t = m0 + row;
      const int pr = t < TP ? t + 1 : t + 2 + ((t - TP) >> 4);
      ra[i] = *(const u32x4*)(A + (size_t)pr * D + k0 + kc * 8);
      rp[i] = *(const u32x4*)(A + (size_t)(pr - 1) * D + k0 + kc * 8);
    }
  }
#pragma unroll
  for (int i = 0; i < BN / 32; ++i) rb[i] = *(const u32x4*)(B + (size_t)(n0 + r0 + 32 * i) * ldb + k0 + kc * 8);
  if (MIX) { rm[0] = *(const f32x4*)(mu + k0 + kc * 8); rm[1] = *(const f32x4*)(mu + k0 + kc * 8 + 4); }
}
template <int MIX, int BN>
DEV void gemm_lstore(char* sA, char* sB, int tid, const u32x4 (&ra)[4], const u32x4 (&rp)[4], const f32x4 (&rm)[2], const u32x4 (&rb)[BN / 32]) {
  const int kc = tid & 7, r0 = tid >> 3;
#pragma unroll
  for (int i = 0; i < 4; ++i) {
    u32x4 o = ra[i];
    if (MIX) {
#pragma unroll
      for (int e = 0; e < 4; ++e) {
        const float h0 = bflo(ra[i][e]), h1 = bfhi(ra[i][e]), p0 = bflo(rp[i][e]), p1 = bfhi(rp[i][e]);
        const float ma = (e < 2) ? rm[0][2 * e] : rm[1][2 * e - 4], mb = (e < 2) ? rm[0][2 * e + 1] : rm[1][2 * e - 3];
        o[e] = pk2(h0 + (p0 - h0) * ma, h1 + (p1 - h1) * mb);
      }
    }
    *(u32x4*)(sA + (r0 + 32 * i) * LDT + kc * 16) = o;
  }
#pragma unroll
  for (int i = 0; i < BN / 32; ++i) *(u32x4*)(sB + (r0 + 32 * i) * LDT + kc * 16) = rb[i];
}

struct PV { f32x4 a, b; };
struct NoPre { DEV PV operator()(int, int) const { PV z; z.a = (f32x4){0.f, 0.f, 0.f, 0.f}; z.b = z.a; return z; } };
template <int MIX, int BN = 128, class Epi, class Pre = NoPre>
DEV void gemm_tile(const bf16_t* A, int lda, const bf16_t* B, int ldb, int K, int m0, int n0, char* smem, const float* mu, Epi epi, Pre pre = Pre()) {
  constexpr int PD = BN == 256 ? 1 : (MIX ? 2 : 3);
  constexpr int NI = BN / 64;
  char* sA = smem; char* sB = smem + 128 * LDT;
  const int tid = otid(), lane = tid & 63, wid = tid >> 6, wr = wid >> 1, wc = wid & 1, h = lane >> 5, r = lane & 31;
  f32x16 acc[2][NI];
#pragma unroll
  for (int a = 0; a < 2; ++a)
#pragma unroll
    for (int b = 0; b < NI; ++b)
#pragma unroll
      for (int i = 0; i < 16; ++i) acc[a][b][i] = 0.f;
  u32x4 ra[PD][4], rp[PD][4], rb[PD][BN / 32]; f32x4 rm[PD][2];
  const int nk = K >> 6;
#pragma unroll
  for (int u = 0; u < PD; ++u) if (u < nk) gemm_gload<MIX, BN>(A, lda, B, ldb, m0, n0, u * 64, tid, ra[u], rp[u], rm[u], rb[u], mu);
  for (int kt0 = 0; kt0 < nk; kt0 += PD) {
#pragma unroll
    for (int u = 0; u < PD; ++u) {
      const int kt = kt0 + u;
      if (kt < nk) {
        LBAR();
        gemm_lstore<MIX, BN>(sA, sB, tid, ra[u], rp[u], rm[u], rb[u]);
        LBAR();
        if (kt + PD < nk) gemm_gload<MIX, BN>(A, lda, B, ldb, m0, n0, (kt + PD) * 64, tid, ra[u], rp[u], rm[u], rb[u], mu);
#pragma unroll
        for (int s = 0; s < 4; ++s) {
          const bf16x8 a0 = *(const bf16x8*)(sA + (wr * 64 + r) * LDT + s * 32 + h * 16);
          const bf16x8 a1 = *(const bf16x8*)(sA + (wr * 64 + 32 + r) * LDT + s * 32 + h * 16);
#pragma unroll
          for (int ni = 0; ni < NI; ++ni) {
            const bf16x8 bq = *(const bf16x8*)(sB + (wc * (BN / 2) + ni * 32 + r) * LDT + s * 32 + h * 16);
            acc[0][ni] = MFMA32(a0, bq, acc[0][ni]);
            acc[1][ni] = MFMA32(a1, bq, acc[1][ni]);
          }
        }
      }
    }
  }
  __builtin_amdgcn_sched_barrier(0);
  LBAR();
  constexpr int NIP = NI >= 2 ? 2 : 1;
  constexpr int SW = 32 * NIP + 4;
  constexpr int LPR = 8 * NIP;
  constexpr int RPI = 64 / LPR;
  float* stg = (float*)smem + wid * (32 * 68);
#pragma unroll
  for (int mi = 0; mi < 2; ++mi)
#pragma unroll
    for (int np = 0; np < NI / NIP; ++np) {
#pragma unroll
      for (int nn = 0; nn < NIP; ++nn)
#pragma unroll
        for (int i = 0; i < 16; ++i) stg[crow(i, h) * SW + 32 * nn + r] = acc[mi][np * NIP + nn][i];
#pragma unroll
      for (int it0 = 0; it0 < 32 / RPI; it0 += 4) {
        PV pv[4];
#pragma unroll
        for (int q = 0; q < 4; ++q) {
          const int rr = (it0 + q) * RPI + lane / LPR, c4 = (lane % LPR) * 4;
          pv[q] = pre(m0 + wr * 64 + mi * 32 + rr, n0 + wc * (BN / 2) + np * NIP * 32 + c4);
        }
#pragma unroll
        for (int q = 0; q < 4; ++q) {
          const int rr = (it0 + q) * RPI + lane / LPR, c4 = (lane % LPR) * 4;
          const f32x4 v = *(const f32x4*)(stg + rr * SW + c4);
          epi(m0 + wr * 64 + mi * 32 + rr, n0 + wc * (BN / 2) + np * NIP * 32 + c4, v, pv[q]);
        }
      }
    }
}

DEV void transpose_tile(const float* src, int ld, int kv, int c0, int cv, int special, bf16_t* dst, int ldd, int tt, char* smem) {
  const int tid = otid();
  const int nkt = ldd >> 6;
  const int n0 = (tt / nkt) * 64, k0 = (tt % nkt) * 64;
  float* tile = (float*)smem;
  const int nn = tid & 63;
  int scol; bool cvld;
  { const int gi = n0 + nn;
    if (special) { cvld = gi < 12; scol = gi < 8 ? 2048 + gi : 3592 + (gi - 8); }
    else { cvld = gi < cv; scol = c0 + gi; } }
  const int scl = cvld ? scol : 0;
  float tv[16];
#pragma unroll
  for (int i = 0; i < 16; ++i) {
    const int k = k0 + (tid >> 6) + 4 * i;
    tv[i] = src[(size_t)(k < kv ? k : kv - 1) * ld + scl];
  }
#pragma unroll
  for (int i = 0; i < 16; ++i) {
    const int kk = (tid >> 6) + 4 * i, k = k0 + kk;
    tile[kk * 65 + nn] = (cvld && k < kv) ? tv[i] : 0.f;
  }
  __syncthreads();
  const int kk2 = (tid & 31) * 2;
#pragma unroll
  for (int i = 0; i < 8; ++i) {
    const int nn2 = (tid >> 5) + 8 * i;
    *(unsigned*)(dst + (size_t)(n0 + nn2) * ldd + k0 + kk2) = pk2(tile[kk2 * 65 + nn2], tile[(kk2 + 1) * 65 + nn2]);
  }
}
constexpr int ADA_TASKS = 384;

DEV void phase0(const P& p, char* smem) {
  const int tid = otid();
  if (blockIdx.x == 0 && tid < 32) ((unsigned*)(p.ws + O_CTR))[tid] = 0u;
  if (blockIdx.x == 0 && tid == 64) {
    float mq = 0.f, mk = 0.f;
    for (int i = 0; i < 128; ++i) { mq = fmaxf(mq, fabsf(p.in[20][i])); mk = fmaxf(mk, fabsf(p.in[21][i])); }
    ((float*)(p.ws + O_CTR))[40] = 106.f + 2.f * mq * mk * 11.313708499f;
  }
  constexpr int ttiles = (2048/64)*16 + (1536/64)*16 + 2*16 + 16*16 + 64*16 + 16*64 + 3*16*16 + 2*16 + 2*16 + 4*16 + 16 + 16 + 16*3 + 16*16 + 64*16 + 16*64;
  const int total = ADA_TASKS + ttiles;
  for (int task = blockIdx.x; task < total; task += gridDim.x) {
    __syncthreads();
    if (task < ADA_TASKS) {
      const int layer = task / 192, j0 = (task % 192) * 32;
      const float* aw = layer ? p.in[26] : p.in[11]; const float* ab = layer ? p.in[27] : p.in[12];
      float* sc = (float*)smem;
      float* red = sc + 9 * 1024;
      for (int e = tid; e < 9 * 1024; e += NTHREADS) {
        const int s_ = e >> 10, k = e & 1023;
        const float c = s_ == 0 ? p.in[2][k] : p.in[3][(s_ - 1) * 1024 + k];
        sc[e] = siluf_(c);
      }
      __syncthreads();
      const int kp = tid >> 5, jj = tid & 31;
      float part[9];
#pragma unroll
      for (int s_ = 0; s_ < 9; ++s_) part[s_] = 0.f;
      const float* wp = aw + (size_t)(kp * 128) * 6144 + j0 + jj;
      for (int k0 = 0; k0 < 128; k0 += 16) {
        float wv[16];
#pragma unroll
        for (int u = 0; u < 16; ++u) wv[u] = wp[(size_t)(k0 + u) * 6144];
#pragma unroll
        for (int u = 0; u < 16; ++u)
#pragma unroll
          for (int s_ = 0; s_ < 9; ++s_) part[s_] += sc[s_ * 1024 + kp * 128 + k0 + u] * wv[u];
      }
#pragma unroll
      for (int s_ = 0; s_ < 9; ++s_) red[(kp * 9 + s_) * 32 + jj] = part[s_];
      __syncthreads();
      float* mod = (float*)(p.ws + O_MOD) + (size_t)layer * 9 * 6144;
      for (int o = tid; o < 288; o += NTHREADS) {
        const int s_ = o >> 5, j = o & 31;
        float v = ab[j0 + j];
#pragma unroll
        for (int q = 0; q < 8; ++q) v += red[(q * 9 + s_) * 32 + j];
        mod[s_ * 6144 + j0 + j] = v;
      }
    } else {
      int tt = task - ADA_TASKS;
      char* w = p.ws;
#define TRY_T(SRC, LD, KV, C0, CV, SP, DST, LDD, NROWS) { const int nt_ = ((NROWS) >> 6) * ((LDD) >> 6); if (tt >= 0 && tt < nt_) transpose_tile(SRC, LD, KV, C0, CV, SP, DST, LDD, tt, smem); tt -= nt_; }
      TRY_T(p.in[15], 3596, 1024, 0, 2048, 0, (bf16_t*)(w + O_WIN), 1024, 2048)
      TRY_T(p.in[15], 3596, 1024, 2056, 1536, 0, (bf16_t*)(w + O_WIN) + 2048 * 1024, 1024, 1536)
      TRY_T(p.in[15], 3596, 1024, 0, 12, 1, (bf16_t*)(w + O_WIN) + 3584 * 1024, 1024, 128)
      TRY_T(p.in[23], 1024, 1024, 0, 1024, 0, (bf16_t*)(w + O_WOUT), 1024, 1024)
      TRY_T(p.in[24], 4096, 1024, 0, 4096, 0, (bf16_t*)(w + O_FF1_0), 1024, 4096)
      TRY_T(p.in[25], 1024, 4096, 0, 1024, 0, (bf16_t*)(w + O_FF2_0), 4096, 1024)
      TRY_T(p.in[31], 1024, 1024, 0, 1024, 0, (bf16_t*)(w + O_RKV), 1024, 1024)
      TRY_T(p.in[32], 1024, 1024, 0, 1024, 0, (bf16_t*)(w + O_RKV) + 1024 * 1024, 1024, 1024)
      TRY_T(p.in[33], 1024, 1024, 0, 1024, 0, (bf16_t*)(w + O_RKV) + 2048 * 1024, 1024, 1024)
      TRY_T(p.in[35], 64, 1024, 0, 64, 0, (bf16_t*)(w + O_LORA1), 1024, 128)
      TRY_T(p.in[38], 64, 1024, 0, 64, 0, (bf16_t*)(w + O_LORA1) + 128 * 1024, 1024, 128)
      TRY_T(p.in[40], 160, 1024, 0, 160, 0, (bf16_t*)(w + O_LORA1) + 256 * 1024, 1024, 256)
      TRY_T(p.in[36], 1024, 64, 0, 1024, 0, (bf16_t*)(w + O_W2), 64, 1024)
      TRY_T(p.in[39], 1024, 64, 0, 1024, 0, (bf16_t*)(w + O_A2), 64, 1024)
      TRY_T(p.in[41], 1024, 160, 0, 1024, 0, (bf16_t*)(w + O_G2), 192, 1024)
      TRY_T(p.in[47], 1024, 1024, 0, 1024, 0, (bf16_t*)(w + O_WO), 1024, 1024)
      TRY_T(p.in[48], 4096, 1024, 0, 4096, 0, (bf16_t*)(w + O_FF1_1), 1024, 4096)
      TRY_T(p.in[49], 1024, 4096, 0, 1024, 0, (bf16_t*)(w + O_FF2_1), 4096, 1024)
    }
  }
}

DEV void rownorm_phase(const P& p, const float* src_or_null, const float* gain, int layer, int shidx, int scidx, bf16_t* dst, int mode) {
  const int tid_ = otid(); const int lane = tid_ & 63, wid = tid_ >> 6;
  const float* mod = (const float*)(p.ws + O_MOD) + (size_t)layer * 9 * 6144;
  const int nrows = mode == 1 ? T + 9 : T;
  for (int row = blockIdx.x * 4 + wid; row < nrows; row += gridDim.x * 4) {
    if (row >= T) {
      const int s = row - T;
      const int pr = s == 0 ? 0 : TP + 1 + 17 * (s - 1);
#pragma unroll
      for (int j = 0; j < 4; ++j) {
        const int c = lane * 4 + 256 * j;
        f32x4 v = {0.f, 0.f, 0.f, 0.f};
        if (s > 0) v = *(const f32x4*)(p.in[9] + (size_t)(s - 1) * D + c);
        u32x2 o; o[0] = pk2(v[0], v[1]); o[1] = pk2(v[2], v[3]);
        *(u32x2*)(dst + (size_t)pr * D + c) = o;
      }
      continue;
    }
    const float* src = src_or_null ? src_or_null + (size_t)row * D : xin_row(p, row);
    f32x4 v[4]; float ss = 0.f;
#pragma unroll
    for (int j = 0; j < 4; ++j) { v[j] = *(const f32x4*)(src + lane * 4 + 256 * j); ss += v[j][0] * v[j][0] + v[j][1] * v[j][1] + v[j][2] * v[j][2] + v[j][3] * v[j][3]; }
    ss = wave_sum(ss);
    const float rstd = rsqrtf(ss * (1.f / 1024.f) + 1e-6f);
    const int st = stream_of(row);
    const float* sh = mod + st * 6144 + shidx * 1024; const float* sc = mod + st * 6144 + scidx * 1024;
    size_t drow = row;
    if (mode == 1) drow = row < TP ? row + 1 : row + 2 + ((row - TP) >> 4);
    const bool last = mode == 1 && (row == TP - 1 || (row >= TP && ((row - TP) & 15) == 15));
    f32x4 gq[4], aq[4], bq_[4];
#pragma unroll
    for (int j = 0; j < 4; ++j) { const int c = lane * 4 + 256 * j; gq[j] = *(const f32x4*)(gain + c); aq[j] = *(const f32x4*)(sh + c); bq_[j] = *(const f32x4*)(sc + c); }
#pragma unroll
    for (int j = 0; j < 4; ++j) {
      const int c = lane * 4 + 256 * j;
      const f32x4 g = gq[j], a = aq[j], b = bq_[j];
      f32x4 o;
#pragma unroll
      for (int e = 0; e < 4; ++e) o[e] = v[j][e] * rstd * g[e] * (1.f + b[e]) + a[e];
      u32x2 ob; ob[0] = pk2(o[0], o[1]); ob[1] = pk2(o[2], o[3]);
      *(u32x2*)(dst + drow * D + c) = ob;
      if (last) *(f32x4*)(p.out + OUT_SHIFT + (size_t)st * D + c) = o;
    }
  }
}

DEV void fox_prep_tile(const P& p, int tile, char* smem) {
  const int tid = otid(), lane = tid & 63, wid = tid >> 6;
  float* lf = (float*)smem;
  bf16_t* proj = (bf16_t*)(p.ws + O_PROJ);
  const float* pab = (const float*)(p.ws + O_PAB);
  const float* qn = p.in[20]; const float* kn = p.in[21]; const float* fb = p.in[22];
  __syncthreads();
  for (int rr = wid * 32; rr < wid * 32 + 32; ++rr) {
    const int row = tile * 128 + rr;
    bf16_t* pr = proj + (size_t)row * NPROJ;
    unsigned uq[4], uk[4], uv[4];
#pragma unroll
    for (int hd = 0; hd < 4; ++hd) {
      const int c = hd * 128 + lane * 2;
      uq[hd] = *(const unsigned*)(pr + 2048 + c); uk[hd] = *(const unsigned*)(pr + 2560 + c); uv[hd] = *(const unsigned*)(pr + 3072 + c);
    }
    const float qn0 = qn[lane * 2], qn1 = qn[lane * 2 + 1], kn0 = kn[lane * 2], kn1 = kn[lane * 2 + 1];
#pragma unroll
    for (int hd = 0; hd < 4; ++hd) {
      const int c = hd * 128 + lane * 2;
      { const float a = bflo(uq[hd]), b = bfhi(uq[hd]);
        const float ss = wave_sum(a * a + b * b); const float rs = rsqrtf(ss * (1.f / 128.f) + 1e-6f) * 0.08838834764831845f * LOG2E;
        *(unsigned*)(pr + 2048 + c) = pk2(a * rs * qn0, b * rs * qn1); }
      { const float a = bflo(uk[hd]), b = bfhi(uk[hd]);
        const float ss = wave_sum(a * a + b * b); const float rs = rsqrtf(ss * (1.f / 128.f) + 1e-6f);
        f32x2 o = {a * rs * kn0, b * rs * kn1};
        *(f32x2*)(p.out + OUT_FK + (size_t)row * 512 + c) = o; }
      { f32x2 o = {bflo(uv[hd]), bfhi(uv[hd])};
        *(f32x2*)(p.out + OUT_FV + (size_t)row * 512 + c) = o; }
    }
    if (lane < 4) {
      const float f = logsigmoidf_(pab[(size_t)row * 16 + 8 + lane] + fb[lane]);
      p.out[OUT_LOGF + (size_t)row * 4 + lane] = f;
      lf[rr * 4 + lane] = f;
    }
  }
  __syncthreads();
  if (tid < 4) {
    float* cl = (float*)(p.ws + O_CL); float run = 0.f;
    for (int rr = 0; rr < 128; ++rr) { run += lf[rr * 4 + tid]; cl[(size_t)(tile * 128 + rr) * 4 + tid] = run; }
    ((float*)(p.ws + O_TOT))[tile * 4 + tid] = run;
  }
}

DEV int img_off128(int l, int k) {
  const int p = perm16(k & 15); const int cidx = (k >> 4) * 2 + (p >> 3);
  return l * 256 + ((cidx ^ (l & 15)) << 4) + (p & 7) * 2;
}
DEV int img_off64(int rowi, int j) {
  const int p = perm16(j & 15); const int cidx = (j >> 4) * 2 + (p >> 3);
  return rowi * 128 + ((cidx ^ ((rowi >> 1) & 7)) << 4) + (p & 7) * 2;
}

struct ConvCtx { const bf16_t* proj; const float* cache; const float* cw; int row0, L, first, stream; };
DEV float conv_raw(const ConvCtx& c, int rr, int ch) {
  if (rr >= 0) return bf2f(c.proj[(size_t)(c.row0 + rr) * NPROJ + ch]);
  if (!c.first) return bf2f(c.proj[(size_t)(c.row0 + rr) * NPROJ + ch]);
  if (c.stream == 0) return 0.f;
  return c.cache[((size_t)(c.stream - 1) * 3 + (3 + rr)) * 1536 + ch];
}

DEV void gdn_prep_item(const P& p, int item, char* smem) {
  const int tid = otid(), lane = tid & 63, wid = tid >> 6;
  const int ci = item >> 2, hd = item & 3;
  ConvCtx cc; cc.proj = (const bf16_t*)(p.ws + O_PROJ); cc.cache = p.in[4]; cc.cw = p.in[16];
  if (ci < 256) { cc.row0 = ci * 64; cc.L = 64; cc.stream = 0; cc.first = ci == 0; }
  else { cc.row0 = TP + (ci - 256) * 16; cc.L = 16; cc.stream = 1 + (ci - 256); cc.first = 1; }
  const int L = cc.L;
  float* ks = (float*)smem;
  float* As = ks + 64 * 132;
  float* sbeta = As + 64 * 68;
  float* sg = sbeta + 64, *sgc = sg + 64, *seg = sgc + 64;
  const float* pab = (const float*)(p.ws + O_PAB);
  char* img = p.ws + O_GIMG + (size_t)item * GIMG_BYTES;
  __syncthreads();
  {
    const int c = tid & 127, half = tid >> 7, ch = 512 + hd * 128 + c;
    const float w0 = cc.cw[ch], w1 = cc.cw[1536 + ch], w2 = cc.cw[2 * 1536 + ch], w3 = cc.cw[3 * 1536 + ch];
    const int rbeg = half * 32;
    float xr[35];
#pragma unroll
    for (int i = 0; i < 3; ++i) { const int rr = rbeg - 3 + i; xr[i] = (rr < L) ? conv_raw(cc, rr, ch) : 0.f; }
#pragma unroll
    for (int i = 3; i < 35; ++i) { const int rr = rbeg - 3 + i; const float t_ = bf2f(cc.proj[(size_t)(cc.row0 + (rr < L ? rr : L - 1)) * NPROJ + ch]); xr[i] = (rr < L) ? t_ : 0.f; }
#pragma unroll
    for (int i = 0; i < 32; ++i) {
      const int rr = rbeg + i; float o = 0.f;
      if (rr < L) o = siluf_(xr[i] * w0 + xr[i + 1] * w1 + xr[i + 2] * w2 + xr[i + 3] * w3);
      ks[rr * 132 + c] = o;
    }
  }
  if (tid < 64) {
    const int rr = tid; float be = 0.f, g = 0.f;
    if (rr < L) {
      const float braw = pab[(size_t)(cc.row0 + rr) * 16 + hd], araw = pab[(size_t)(cc.row0 + rr) * 16 + 4 + hd];
      be = sigmoidf_(braw); g = -__expf(p.in[17][hd]) * softplusf_(araw + p.in[18][hd]);
    }
    sbeta[rr] = be; sg[rr] = g;
  }
  __syncthreads();
  for (int rr = wid * 16; rr < wid * 16 + 16; ++rr) {
    const float a = ks[rr * 132 + lane], b = ks[rr * 132 + lane + 64];
    const float ss = wave_sum(a * a + b * b); const float rs = rsqrtf(ss + 1e-6f);
    ks[rr * 132 + lane] = a * rs; ks[rr * 132 + lane + 64] = b * rs;
  }
  if (tid == 0) {
    float run = 0.f;
    for (int rr = 0; rr < 64; ++rr) { run += sg[rr]; sgc[rr] = run; seg[rr] = __expf(run); }
    ((float*)(p.ws + O_GL))[item] = run;
  }
  __syncthreads();
  {
    const int ti = tid >> 4, tj = tid & 15;
    float acc[4][4];
#pragma unroll
    for (int a = 0; a < 4; ++a)
#pragma unroll
      for (int b = 0; b < 4; ++b) acc[a][b] = 0.f;
    for (int d = 0; d < 128; d += 4) {
      f32x4 ka[4], kb[4];
#pragma unroll
      for (int a = 0; a < 4; ++a) { ka[a] = *(const f32x4*)(ks + (ti + 16 * a) * 132 + d); kb[a] = *(const f32x4*)(ks + (tj + 16 * a) * 132 + d); }
#pragma unroll
      for (int a = 0; a < 4; ++a)
#pragma unroll
        for (int b = 0; b < 4; ++b) acc[a][b] += ka[a][0] * kb[b][0] + ka[a][1] * kb[b][1] + ka[a][2] * kb[b][2] + ka[a][3] * kb[b][3];
    }
#pragma unroll
    for (int a = 0; a < 4; ++a)
#pragma unroll
      for (int b = 0; b < 4; ++b) {
        const int i = ti + 16 * a, j = tj + 16 * b;
        As[i * 68 + j] = (j < i) ? sbeta[i] * acc[a][b] * __expf(sgc[i] - sgc[j]) : 0.f;
      }
  }
  __syncthreads();
  {
    float x[64];
    if (tid < 128) {
      const int c = tid, ch = 1024 + hd * 128 + c;
      const float w0 = cc.cw[ch], w1 = cc.cw[1536 + ch], w2 = cc.cw[2 * 1536 + ch], w3 = cc.cw[3 * 1536 + ch];
      float x0 = conv_raw(cc, -3, ch), x1 = conv_raw(cc, -2, ch), x2 = conv_raw(cc, -1, ch);
#pragma unroll
      for (int rr = 0; rr < 64; ++rr) x[rr] = bf2f(cc.proj[(size_t)(cc.row0 + (rr < L ? rr : L - 1)) * NPROJ + ch]);
#pragma unroll
      for (int rr = 0; rr < 64; ++rr) {
        const float x3 = x[rr];
        x[rr] = (rr < L) ? siluf_(x0 * w0 + x1 * w1 + x2 * w2 + x3 * w3) * sbeta[rr] : 0.f;
        x0 = x1; x1 = x2; x2 = x3;
      }
    } else {
      const int c = tid - 128;
#pragma unroll
      for (int rr = 0; rr < 64; ++rr) x[rr] = ks[rr * 132 + c] * sbeta[rr] * seg[rr];
    }
#pragma unroll
    for (int i = 1; i < 64; ++i) {
      float a = x[i];
#pragma unroll
      for (int j4 = 0; j4 < (i + 3) / 4; ++j4) {
        const f32x4 av = *(const f32x4*)(As + i * 68 + j4 * 4);
        a -= av[0] * x[4 * j4 + 0];
        if (4 * j4 + 1 < i) a -= av[1] * x[4 * j4 + 1];
        if (4 * j4 + 2 < i) a -= av[2] * x[4 * j4 + 2];
        if (4 * j4 + 3 < i) a -= av[3] * x[4 * j4 + 3];
      }
      x[i] = a;
      __builtin_amdgcn_sched_barrier(0);
    }
    if (tid < 128) {
      const int c = tid, w = c >> 5, ll = c & 31;
      bf16_t* uvb = (bf16_t*)(img + 57344) + (w * 128 + ll) * 16;
#pragma unroll
      for (int rr = 0; rr < 64; ++rr) {
        const int mt = rr >> 5, r5 = rr & 31, hh = (r5 >> 2) & 1, ii = (r5 & 3) + 4 * (r5 >> 3);
        uvb[(mt * 64 + 32 * hh) * 16 + ii] = f2bf(x[rr]);
        if ((rr & 7) == 7) __builtin_amdgcn_sched_barrier(0);
      }
    } else {
      const int c = tid - 128;
      const int pp = perm16(c & 15), cidx = (c >> 4) * 2 + (pp >> 3);
#pragma unroll
      for (int q = 0; q < 16; ++q) {
        char* bq = img + q * 256 + ((cidx ^ q) << 4) + (pp & 7) * 2;
#pragma unroll
        for (int g = 0; g < 4; ++g) *(bf16_t*)(bq + g * 4096) = f2bf(-x[16 * g + q]);
        __builtin_amdgcn_sched_barrier(0);
      }
    }
  }
  __syncthreads();
  float* qs = As;
  for (int hq = 0; hq < 2; ++hq) {
    {
      const int c = tid & 127, sub = tid >> 7, ch = hd * 128 + c;
      const float w0 = cc.cw[ch], w1 = cc.cw[1536 + ch], w2 = cc.cw[2 * 1536 + ch], w3 = cc.cw[3 * 1536 + ch];
      const int rbeg = hq * 32 + sub * 16;
      float xr[19];
#pragma unroll
      for (int i = 0; i < 3; ++i) { const int rr = rbeg - 3 + i; xr[i] = (rr < L) ? conv_raw(cc, rr, ch) : 0.f; }
#pragma unroll
      for (int i = 3; i < 19; ++i) { const int rr = rbeg - 3 + i; const float t_ = bf2f(cc.proj[(size_t)(cc.row0 + (rr < L ? rr : L - 1)) * NPROJ + ch]); xr[i] = (rr < L) ? t_ : 0.f; }
#pragma unroll
      for (int i = 0; i < 16; ++i) {
        const int rr = rbeg + i; float o = 0.f;
        if (rr < L) o = siluf_(xr[i] * w0 + xr[i + 1] * w1 + xr[i + 2] * w2 + xr[i + 3] * w3);
        qs[(rr - hq * 32) * 132 + c] = o;
      }
    }
    __syncthreads();
    for (int lr = wid * 8; lr < wid * 8 + 8; ++lr) {
      const float a = qs[lr * 132 + lane], b = qs[lr * 132 + lane + 64];
      const float ss = wave_sum(a * a + b * b); const float rs = rsqrtf(ss + 1e-6f) * 0.08838834764831845f;
      qs[lr * 132 + lane] = a * rs; qs[lr * 132 + lane + 64] = b * rs;
    }
    __syncthreads();
    {
      const int c = tid & 127, sub = tid >> 7;
      for (int i = 0; i < 16; ++i) {
        const int lr = sub * 16 + i, rr = hq * 32 + lr;
        *(bf16_t*)(img + 16384 + img_off128(rr, c)) = f2bf(qs[lr * 132 + c] * seg[rr]);
      }
      const int ti = tid >> 4, tj = tid & 15;
      float acc[2][4];
#pragma unroll
      for (int a = 0; a < 2; ++a)
#pragma unroll
        for (int b = 0; b < 4; ++b) acc[a][b] = 0.f;
      for (int d = 0; d < 128; d += 4) {
        f32x4 qa[2], kb[4];
#pragma unroll
        for (int a = 0; a < 2; ++a) qa[a] = *(const f32x4*)(qs + (ti + 16 * a) * 132 + d);
#pragma unroll
        for (int b = 0; b < 4; ++b) kb[b] = *(const f32x4*)(ks + (tj + 16 * b) * 132 + d);
#pragma unroll
        for (int a = 0; a < 2; ++a)
#pragma unroll
          for (int b = 0; b < 4; ++b) acc[a][b] += qa[a][0] * kb[b][0] + qa[a][1] * kb[b][1] + qa[a][2] * kb[b][2] + qa[a][3] * kb[b][3];
      }
#pragma unroll
      for (int a = 0; a < 2; ++a)
#pragma unroll
        for (int b = 0; b < 4; ++b) {
          const int i = hq * 32 + ti + 16 * a, j = tj + 16 * b;
          const float v = (j <= i) ? acc[a][b] * __expf(sgc[i] - sgc[j]) : 0.f;
          *(bf16_t*)(img + 32768 + img_off64(i, j)) = f2bf(v);
        }
    }
    __syncthreads();
  }
  {
    const int c = tid & 127, lb = (tid >> 7) * 32;
    const float glast = sgc[63];
    for (int i = 0; i < 32; ++i) {
      const int l = lb + i;
      *(bf16_t*)(img + 40960 + img_off64(c, l)) = f2bf(ks[l * 132 + c] * __expf(glast - sgc[l]));
    }
  }
}

DEV void gdn_scan_item(const P& p, int sitem, char* smem) {
  const int tid = otid(), lane = tid & 63, w = tid >> 6, r = lane & 31, h = lane >> 5;
  int stream, hd, half, nchunks, item0, row0, L;
  if (sitem < 8) { stream = 0; hd = sitem >> 1; half = sitem & 1; nchunks = 256; item0 = hd; row0 = 0; L = 64; }
  else { const int n = sitem - 8; const int b = n >> 3; hd = (n >> 1) & 3; half = n & 1; stream = 1 + b; nchunks = 1; item0 = (256 + b) * 4 + hd; row0 = TP + 16 * b; L = 16; }
  __syncthreads();
  if (w >= 2) {
    const unsigned lo = (unsigned)(tid - 128) * 16u;
    u32x4 ra[28];
#define GS_LOAD(REG, C) { const char* img_ = p.ws + O_GIMG + (size_t)(item0 + (C) * 4) * GIMG_BYTES; _Pragma("unroll") for (int i = 0; i < 28; ++i) REG[i] = *(const u32x4*)((img_ + 2048 * i) + lo); }
#define GS_STORE(REG) { _Pragma("unroll") for (int i = 0; i < 28; ++i) *(u32x4*)(smem + 2048 * i + lo) = REG[i]; }
    float* orawl = (float*)(p.ws + O_ORAW);
#define GS_OCOPY(CC) { _Pragma("unroll") for (int i = 0; i < 8; ++i) { const unsigned B_ = 2048u * i + lo; const f32x4 ov_ = *(const f32x4*)(smem + B_); \
        const int w_ = B_ >> 13, row_ = (B_ & 8191u) >> 7, c4_ = ((B_ & 127u) >> 4) * 4; \
        if (row_ < L) *(f32x4*)(orawl + (size_t)(row0 + (CC) * 64 + row_) * 512 + hd * 128 + 32 * (2 * half + w_) + c4_) = ov_; __builtin_amdgcn_sched_barrier(0); } }
    GS_LOAD(ra, 0)
    for (int c = 0; c < nchunks; ++c) {
      LBAR();
      if (c > 0) GS_OCOPY(c - 1)
      GS_STORE(ra)
      LBAR();
      if (c + 1 < nchunks) GS_LOAD(ra, c + 1)
      LBAR();
    }
    LBAR();
    GS_OCOPY(nchunks - 1)
  } else {
    const int vs = 2 * half + w;
    f32x16 S[4];
#pragma unroll
    for (int kt = 0; kt < 4; ++kt)
#pragma unroll
      for (int i = 0; i < 16; ++i) {
        float v = 0.f;
        if (stream > 0) v = p.in[5][(((size_t)(stream - 1) * 4 + hd) * 128 + 32 * kt + crow(i, h)) * 128 + 32 * vs + r];
        S[kt][i] = v;
      }
    const float* gl = (const float*)(p.ws + O_GL);
    float* oraw = (float*)(p.ws + O_ORAW);
    const unsigned uoff = (unsigned)(vs * 128 + lane) * 32u;
    u32x4 pu[4]; float gln;
    int a1[8], a2[4];
#pragma unroll
    for (int q = 0; q < 8; ++q) a1[q] = r * 256 + (((2 * q + h) ^ (r & 15)) << 4);
#pragma unroll
    for (int q = 0; q < 4; ++q) a2[q] = 32768 + r * 128 + (((2 * q + h) ^ ((r >> 1) & 7)) << 4);
    {
      const char* img = p.ws + O_GIMG + (size_t)item0 * GIMG_BYTES;
      gln = gl[item0];
#pragma unroll
      for (int mt = 0; mt < 2; ++mt) { pu[2 * mt] = *(const u32x4*)((img + 57344 + mt * 2048) + uoff); pu[2 * mt + 1] = *(const u32x4*)((img + 57344 + mt * 2048 + 16) + uoff); }
    }
    for (int c = 0; c < nchunks; ++c) {
      const int item = item0 + c * 4;
      LBAR();
      f32x16 U[2], O[2];
#pragma unroll
      for (int mt = 0; mt < 2; ++mt) {
#pragma unroll
        for (int e = 0; e < 4; ++e) { U[mt][2 * e] = bflo(pu[2 * mt][e]); U[mt][2 * e + 1] = bfhi(pu[2 * mt][e]); U[mt][8 + 2 * e] = bflo(pu[2 * mt + 1][e]); U[mt][8 + 2 * e + 1] = bfhi(pu[2 * mt + 1][e]); }
#pragma unroll
        for (int i = 0; i < 16; ++i) O[mt][i] = 0.f;
      }
      const float gamma = __expf(gln);
      if (c + 1 < nchunks) {
        const char* img = p.ws + O_GIMG + (size_t)(item + 4) * GIMG_BYTES;
        gln = gl[item + 4];
#pragma unroll
        for (int mt = 0; mt < 2; ++mt) { pu[2 * mt] = *(const u32x4*)((img + 57344 + mt * 2048) + uoff); pu[2 * mt + 1] = *(const u32x4*)((img + 57344 + mt * 2048 + 16) + uoff); }
      }
      LBAR();
      bf16x8 FA[8], FB[8];
#define LD1(F, KT) { _Pragma("unroll") for (int s_ = 0; s_ < 2; ++s_) { const char* b_ = smem + a1[2 * (KT) + s_]; \
        F[4 * s_ + 0] = *(const bf16x8*)(b_); F[4 * s_ + 1] = *(const bf16x8*)(b_ + 16384); F[4 * s_ + 2] = *(const bf16x8*)(b_ + 8192); F[4 * s_ + 3] = *(const bf16x8*)(b_ + 8192 + 16384); } }
#define MM1(F, KT) { _Pragma("unroll") for (int s_ = 0; s_ < 2; ++s_) { const bf16x8 sf_ = pack8(S[KT], s_); \
        U[0] = MFMA32(F[4 * s_ + 0], sf_, U[0]); O[0] = MFMA32(F[4 * s_ + 1], sf_, O[0]); U[1] = MFMA32(F[4 * s_ + 2], sf_, U[1]); O[1] = MFMA32(F[4 * s_ + 3], sf_, O[1]); } }
#define LD2(F) { _Pragma("unroll") for (int q_ = 0; q_ < 4; ++q_) { const char* b_ = smem + a2[q_]; F[2 * q_] = *(const bf16x8*)(b_); F[2 * q_ + 1] = *(const bf16x8*)(b_ + 4096); } }
#define LD3(F, M2) { _Pragma("unroll") for (int s_ = 0; s_ < 2; ++s_) { const char* b_ = smem + 8192 + a2[2 * (M2) + s_]; _Pragma("unroll") for (int kt_ = 0; kt_ < 4; ++kt_) F[4 * s_ + kt_] = *(const bf16x8*)(b_ + 4096 * kt_); } }
#define MM3(F, M2) { _Pragma("unroll") for (int s_ = 0; s_ < 2; ++s_) { _Pragma("unroll") for (int kt_ = 0; kt_ < 4; ++kt_) S[kt_] = MFMA32(F[4 * s_ + kt_], uf[M2][s_], S[kt_]); } }
#define SB __builtin_amdgcn_sched_barrier(0);
      LD1(FA, 0) SB
      LD1(FB, 1) SB MM1(FA, 0) SB
      LD1(FA, 2) SB MM1(FB, 1) SB
      LD1(FB, 3) SB MM1(FA, 2) SB
      MM1(FB, 3) SB
      LBAR();
      LD2(FA) SB
      bf16x8 uf[2][2];
#pragma unroll
      for (int mt = 0; mt < 2; ++mt)
#pragma unroll
        for (int s = 0; s < 2; ++s) uf[mt][s] = pack8(U[mt], s);
      LD3(FB, 0) SB
#pragma unroll
      for (int q = 0; q < 4; ++q) { O[0] = MFMA32(FA[2 * q], uf[q >> 1][q & 1], O[0]); O[1] = MFMA32(FA[2 * q + 1], uf[q >> 1][q & 1], O[1]); }
      {
        float* os_ = (float*)smem + w * 2048 + 4 * h * 32 + r;
#pragma unroll
        for (int mt = 0; mt < 2; ++mt)
#pragma unroll
          for (int i = 0; i < 16; ++i) os_[(32 * mt + (i & 3) + 8 * (i >> 2)) * 32] = O[mt][i];
      }
#pragma unroll
      for (int kt = 0; kt < 4; ++kt)
#pragma unroll
        for (int i = 0; i < 16; ++i) S[kt][i] *= gamma;
      SB
      LD3(FA, 1) SB MM3(FB, 0) SB
      MM3(FA, 1) SB
    }
    LBAR();
    float* dout = p.out + OUT_DELTA + ((size_t)stream * 4 + hd) * 128 * 128;
#pragma unroll
    for (int kt = 0; kt < 4; ++kt)
#pragma unroll
      for (int i = 0; i < 16; ++i) dout[(size_t)(32 * kt + crow(i, h)) * 128 + 32 * vs + r] = S[kt][i];
  }
}

DEV void fox_attn_item(const P& p, int aitem, char* smem) {
  const int tid = otid(), lane = tid & 63, w = tid >> 6, r = lane & 31, h = lane >> 5;
  int hd, b = 0, qrow0, nq, nkeys, qpos0, ntiles; bool dec;
  if (aitem < 32) { dec = true; b = aitem >> 2; hd = aitem & 3; qrow0 = TP + 16 * b; nq = 16; nkeys = 4112; qpos0 = 4096; ntiles = 129; }
  else { const int n = aitem - 32; dec = false; hd = n & 3; const int qb = 127 - (n >> 2); qrow0 = 128 * qb; nq = 128; nkeys = TP; qpos0 = qrow0; ntiles = ((qrow0 + 127) >> 5) + 1; }
  char* sK = smem; char* sV = smem + 8192;
  float* sck = (float*)(smem + 16384);
  float* sbase = (float*)(smem + 16640);
  float* sred = (float*)(smem + 16640 + 4352 * 4);
  const float* fk = p.out + OUT_FK; const float* fv = p.out + OUT_FV;
  const float* cl = (const float*)(p.ws + O_CL);
  __syncthreads();
  if (!dec) {
    if (tid == 0) { const float* tot = (const float*)(p.ws + O_TOT); float run = 0.f; for (int t = 0; t < 128; ++t) { sbase[t] = run; run += tot[t * 4 + hd]; } sbase[128] = run; }
  } else {
    float run = 0.f;
#pragma unroll 1
    for (int e = 0; e < 17; ++e) {
      const int j = tid * 17 + e; float v = 0.f;
      if (j < 4096) v = p.in[8][((size_t)b * 4096 + j) * 4 + hd];
      else if (j < 4112) v = p.out[OUT_LOGF + (size_t)(TP + 16 * b + (j - 4096)) * 4 + hd];
      run += v; sbase[j] = run;
    }
    sred[tid] = run;
    __syncthreads();
    if (tid == 0) { float a = 0.f; for (int t = 0; t < 256; ++t) { const float x = sred[t]; sred[t] = a; a += x; } }
    __syncthreads();
    const float basev = sred[tid];
#pragma unroll 1
    for (int e = 0; e < 17; ++e) sbase[tid * 17 + e] += basev;
  }
  __syncthreads();
  int kt_lo = 0;
  {
    const float thr = ((const float*)(p.ws + O_CTR))[40];
    if (!dec) {
      const float ci0 = sbase[qrow0 >> 7] + cl[(size_t)qrow0 * 4 + hd];
      int tb = 0;
      while (tb < (qrow0 >> 7) && ci0 - sbase[tb + 1] < -thr) ++tb;
      kt_lo = 4 * tb;
    } else {
      const float ci0 = sbase[4096];
      while (kt_lo < 128 && ci0 - sbase[32 * kt_lo + 31] < -thr) ++kt_lo;
    }
  }
  const bool active = 32 * w < nq;
  const int qi = 32 * w + r;
  const bool qvalid = qi < nq;
  const int qrow = qrow0 + (qvalid ? qi : 0);
  const int qpos = qpos0 + qi;
  float cq;
  if (!dec) cq = sbase[qpos >> 7] + cl[(size_t)qpos * 4 + hd]; else cq = sbase[qvalid ? qpos : 4096];
  cq *= LOG2E;
  bf16x8 qf[8];
  {
    const bf16_t* qp = (const bf16_t*)(p.ws + O_PROJ) + (size_t)qrow * NPROJ + 2048 + hd * 128 + 8 * h;
#pragma unroll
    for (int ks = 0; ks < 8; ++ks) qf[ks] = *(const bf16x8*)(qp + 16 * ks);
  }
  f32x16 O[4];
#pragma unroll
  for (int dt = 0; dt < 4; ++dt)
#pragma unroll
    for (int i = 0; i < 16; ++i) O[dt][i] = 0.f;
  float m = -1e30f, lsum = 0.f;
  const int kkl = tid >> 3, ksub = tid & 7;
  const int vkl = tid & 31, vdg = tid >> 5;
  f32x4 kreg[4], vreg[4]; float ckreg = 0.f;
  auto krow_ptr = [&](const float* base_out, const float* cache, int j) -> const float* {
    j = j < nkeys ? j : nkeys - 1;
    const float* p_new = base_out + ((size_t)(dec ? TP + 16 * b + (j - 4096) : j) * 4 + hd) * 128;
    const float* p_old = cache + (((size_t)b * 4096 + (j < 4096 ? j : 0)) * 4 + hd) * 128;
    return (dec && j < 4096) ? p_old : p_new;
  };
  auto gload = [&](int kt) {
    const float* kp = krow_ptr(fk, p.in[6], kt * 32 + kkl);
    const float* vp = krow_ptr(fv, p.in[7], kt * 32 + vkl);
#pragma unroll
    for (int e = 0; e < 4; ++e) {
      kreg[e] = *(const f32x4*)(kp + 16 * ksub + 4 * e);
      vreg[e] = *(const f32x4*)(vp + 16 * vdg + 4 * e);
    }
    if (tid < 32) {
      const int j = kt * 32 + tid;
      float c = 0.f;
      if (j < nkeys) c = dec ? sbase[j] : sbase[j >> 7] + cl[(size_t)j * 4 + hd];
      ckreg = c * LOG2E;
    }
  };
  gload(kt_lo);
  for (int kt = kt_lo; kt < ntiles; ++kt) {
    __syncthreads();
#pragma unroll
    for (int e = 0; e < 2; ++e) {
      const int cidx = ksub * 2 + e;
      u32x4 o; o[0] = pk2(kreg[2 * e][0], kreg[2 * e][1]); o[1] = pk2(kreg[2 * e][2], kreg[2 * e][3]);
      o[2] = pk2(kreg[2 * e + 1][0], kreg[2 * e + 1][1]); o[3] = pk2(kreg[2 * e + 1][2], kreg[2 * e + 1][3]);
      *(u32x4*)(sK + kkl * 256 + ((cidx ^ (kkl & 15)) << 4)) = o;
    }
    {
      const int pos = (vkl & ~15) + perm16(vkl & 15);
#pragma unroll
      for (int e = 0; e < 4; ++e)
#pragma unroll
        for (int f = 0; f < 4; ++f) {
          const int d = 16 * vdg + 4 * e + f;
          *(bf16_t*)(sV + d * 64 + (((pos >> 3) ^ ((d >> 2) & 3)) << 4) + (pos & 7) * 2) = f2bf(vreg[e][f]);
        }
    }
    if (tid < 32) sck[tid] = ckreg;
    __syncthreads();
    if (kt + 1 < ntiles) gload(kt + 1);
    if (active && (kt * 32 <= qpos0 + 32 * w + 31)) {
      f32x16 S;
#pragma unroll
      for (int i = 0; i < 16; ++i) S[i] = 0.f;
#pragma unroll
      for (int ks = 0; ks < 8; ++ks) {
        const bf16x8 a = *(const bf16x8*)(sK + r * 256 + (((2 * ks + h) ^ (r & 15)) << 4));
        S = MFMA32(a, qf[ks], S);
      }
      __builtin_amdgcn_sched_barrier(0);
      float mx = -INFINITY;
#pragma unroll
      for (int g = 0; g < 4; ++g) {
        const f32x4 ck4 = *(const f32x4*)(sck + 8 * g + 4 * h);
#pragma unroll
        for (int e = 0; e < 4; ++e) {
          const int i = 4 * g + e;
          const int kabs = kt * 32 + 8 * g + 4 * h + e;
          float sv = S[i] + (cq - ck4[e]);
          sv = (kabs <= qpos) ? sv : -INFINITY;
          S[i] = sv; mx = fmaxf(mx, sv);
        }
      }
      mx = fmaxf(mx, __shfl_xor(mx, 32));
      const float mn = fmaxf(m, mx);
      const float alpha = __builtin_amdgcn_exp2f(m - mn);
      m = mn;
      float ps = 0.f;
#pragma unroll
      for (int i = 0; i < 16; ++i) { const float pv = __builtin_amdgcn_exp2f(S[i] - mn); S[i] = pv; ps += pv; }
      lsum = lsum * alpha + ps;
#pragma unroll
      for (int dt = 0; dt < 4; ++dt)
#pragma unroll
        for (int i = 0; i < 16; ++i) O[dt][i] *= alpha;
      bf16x8 pf[2];
#pragma unroll
      for (int s = 0; s < 2; ++s) pf[s] = pack8(S, s);
      __builtin_amdgcn_sched_barrier(0);
#pragma unroll
      for (int dt = 0; dt < 4; ++dt)
#pragma unroll
        for (int s = 0; s < 2; ++s) {
          const int d = 32 * dt + r;
          const bf16x8 a = *(const bf16x8*)(sV + d * 64 + (((2 * s + h) ^ ((d >> 2) & 3)) << 4));
          O[dt] = MFMA32(a, pf[s], O[dt]);
        }
    }
  }
  if (active) {
    const float lt = lsum + __shfl_xor(lsum, 32);
    const float inv = 1.f / lt;
    if (qvalid) {
      bf16_t* op = (bf16_t*)(p.ws + O_R1) + (size_t)qrow * D + 512 + hd * 128;
#pragma unroll
      for (int dt = 0; dt < 4; ++dt)
#pragma unroll
        for (int g = 0; g < 4; ++g) {
          u32x2 o; o[0] = pk2(O[dt][4 * g] * inv, O[dt][4 * g + 1] * inv); o[1] = pk2(O[dt][4 * g + 2] * inv, O[dt][4 * g + 3] * inv);
          *(u32x2*)(op + 32 * dt + 8 * g + 4 * h) = o;
        }
    }
  }
}

DEV void wkv_scan_item(const P& p, int item, char* smem) {
  const int tid = otid(), lane = tid & 63, w = tid >> 6;
  int stream, hd, rg, row0, nsteps;
  if (item < 256) { stream = 0; hd = item >> 4; rg = item & 15; row0 = 0; nsteps = TP; }
  else { const int n = item - 256; const int b = n >> 8; stream = 1 + b; hd = (n >> 4) & 15; rg = n & 15; row0 = TP + 16 * b; nsteps = 16; }
  constexpr int BUF = 6 * 1024 + 16 * 8;
  float* bufs = (float*)smem;
  const bf16_t* rkv = (const bf16_t*)(p.ws + O_RKVB);
  const float* dec = (const float*)(p.ws + O_DEC);
  const bf16_t* ab = (const bf16_t*)(p.ws + O_AB);
  bf16_t* yraw = (bf16_t*)(p.ws + O_R1);
  const int nch = nsteps >> 4;
  __syncthreads();
  if (w > 0) {
    const int slot0 = tid - 64;
    const bool two = slot0 < 64;
    u32x2 rr_[4][2], kr_[4][2], vr_[4][2], ar_[4][2], kn_[4][2]; f32x4 dr_[4][2];
#define WKV_GLOAD(SET, C) { if ((C) < nch) { _Pragma("unroll") for (int q = 0; q < 2; ++q) { if (q == 1 && !two) break; \
        const int slot = slot0 + 192 * q; const int ltok = slot >> 4, ch = hd * 64 + (slot & 15) * 4; const size_t row = row0 + (C) * 16 + ltok; \
        rr_[SET][q] = *(const u32x2*)(rkv + row * 3072 + ch); kr_[SET][q] = *(const u32x2*)(rkv + row * 3072 + 1024 + ch); vr_[SET][q] = *(const u32x2*)(rkv + row * 3072 + 2048 + ch); \
        kn_[SET][q] = *(const u32x2*)(rkv + (row + 1) * 3072 + 1024 + ch); \
        ar_[SET][q] = *(const u32x2*)(ab + row * 1024 + ch); dr_[SET][q] = *(const f32x4*)(dec + row * 1024 + ch); } } }
#define WKV_PREP(SET, BI) { float* bp = bufs + (BI) * BUF; _Pragma("unroll") for (int q = 0; q < 2; ++q) { if (q == 1 && !two) break; \
        const int slot = slot0 + 192 * q; const int ltok = slot >> 4, lc4 = (slot & 15) * 4, ch = hd * 64 + lc4; \
        const f32x4 kkw = *(const f32x4*)(p.in[42] + ch), kaw = *(const f32x4*)(p.in[43] + ch); \
        const f32x4 r4 = {bflo(rr_[SET][q][0]), bfhi(rr_[SET][q][0]), bflo(rr_[SET][q][1]), bfhi(rr_[SET][q][1])}; \
        const f32x4 k4 = {bflo(kr_[SET][q][0]), bfhi(kr_[SET][q][0]), bflo(kr_[SET][q][1]), bfhi(kr_[SET][q][1])}; \
        const f32x4 v4 = {bflo(vr_[SET][q][0]), bfhi(vr_[SET][q][0]), bflo(vr_[SET][q][1]), bfhi(vr_[SET][q][1])}; \
        const f32x4 a4 = {bflo(ar_[SET][q][0]), bfhi(ar_[SET][q][0]), bflo(ar_[SET][q][1]), bfhi(ar_[SET][q][1])}; \
        const f32x4 n4 = {bflo(kn_[SET][q][0]), bfhi(kn_[SET][q][0]), bflo(kn_[SET][q][1]), bfhi(kn_[SET][q][1])}; \
        f32x4 kk4 = k4 * kkw; float ss = kk4[0] * kk4[0] + kk4[1] * kk4[1] + kk4[2] * kk4[2] + kk4[3] * kk4[3]; ss = row16_sum(ss); \
        const float rs = rsqrtf(ss + 1e-6f); kk4 = kk4 * rs; \
        f32x4 kn4 = n4 * kkw; float sn = kn4[0] * kn4[0] + kn4[1] * kn4[1] + kn4[2] * kn4[2] + kn4[3] * kn4[3]; sn = row16_sum(sn); \
        const float rn = rsqrtf(sn + 1e-6f); kn4 = kn4 * rn; \
        f32x4 kp4, b4, z4; float be = 0.f, ka_ = 0.f; \
        _Pragma("unroll") for (int e = 0; e < 4; ++e) { kp4[e] = k4[e] * (1.f + (a4[e] - 1.f) * kaw[e]); b4[e] = -kk4[e] * a4[e]; z4[e] = dr_[SET][q][e] * kn4[e]; be += b4[e] * kn4[e]; ka_ += kp4[e] * kn4[e]; } \
        be = row16_sum(be); ka_ = row16_sum(ka_); \
        *(f32x4*)(bp + 0 * 1024 + ltok * 64 + lc4) = r4; *(f32x4*)(bp + 1 * 1024 + ltok * 64 + lc4) = dr_[SET][q]; \
        *(f32x4*)(bp + 2 * 1024 + ltok * 64 + lc4) = kp4; *(f32x4*)(bp + 3 * 1024 + ltok * 64 + lc4) = kk4; *(f32x4*)(bp + 4 * 1024 + ltok * 64 + lc4) = b4; \
        *(f32x4*)(bp + 5 * 1024 + ltok * 64 + lc4) = z4; \
        if ((slot & 15) == rg) *(f32x4*)(bp + 6 * 1024 + ltok * 8) = v4; \
        if ((slot & 15) == 0) { f32x2 bk_ = {be, ka_}; *(f32x2*)(bp + 6 * 1024 + ltok * 8 + 4) = bk_; } } }
    WKV_GLOAD(0, 0) WKV_GLOAD(1, 1) WKV_GLOAD(2, 2) WKV_GLOAD(3, 3)
    WKV_PREP(0, 0)
    WKV_GLOAD(0, 4)
    LBAR();
    for (int c0 = 0; c0 < nch; c0 += 4) {
      { const int c = c0 + 0; if (c < nch) { if (c + 1 < nch) { WKV_PREP(1, 1) WKV_GLOAD(1, c + 5) } LBAR(); } }
      { const int c = c0 + 1; if (c < nch) { if (c + 1 < nch) { WKV_PREP(2, 0) WKV_GLOAD(2, c + 5) } LBAR(); } }
      { const int c = c0 + 2; if (c < nch) { if (c + 1 < nch) { WKV_PREP(3, 1) WKV_GLOAD(3, c + 5) } LBAR(); } }
      { const int c = c0 + 3; if (c < nch) { if (c + 1 < nch) { WKV_PREP(0, 0) WKV_GLOAD(0, c + 5) } LBAR(); } }
    }
  } else {
    const int rowl = lane >> 4, myrow = 4 * rg + rowl, c4 = (lane & 15) * 4;
    f32x4 st = {0.f, 0.f, 0.f, 0.f};
    if (stream > 0) st = *(const f32x4*)(p.in[10] + (((size_t)(stream - 1) * 16 + hd) * 64 + myrow) * 64 + c4);
    f32x2 slo = {st[0], st[1]}, shi = {st[2], st[3]};
    LBAR();
    float sa;
    { const f32x4 kk0 = *(const f32x4*)(bufs + 3 * 1024 + c4); sa = row16_sum(st[0] * kk0[0] + st[1] * kk0[1] + st[2] * kk0[2] + st[3] * kk0[3]); }
    for (int c = 0; c < nch; ++c) {
      const float* bp = bufs + (c & 1) * BUF;
      const float* bq = bp + c4;
      const float* bv = bp + 6 * 1024 + rowl;
      const float* bk = bp + 6 * 1024 + 4;
      float ykeep = 0.f, yprev = 0.f;
      f32x4 Z[16], W[16], NB[16], K[16], R[16]; float V[16]; f32x2 BK[16];
#define WLD(T) { Z[T] = *(const f32x4*)(bq + 5 * 1024 + (T) * 64); W[T] = *(const f32x4*)(bq + 1 * 1024 + (T) * 64); NB[T] = *(const f32x4*)(bq + 4 * 1024 + (T) * 64); \
        K[T] = *(const f32x4*)(bq + 2 * 1024 + (T) * 64); R[T] = *(const f32x4*)(bq + 0 * 1024 + (T) * 64); V[T] = bv[(T) * 8]; BK[T] = *(const f32x2*)(bk + (T) * 8); }
      WLD(0) WLD(1) WLD(2)
#pragma unroll
      for (int t = 0; t < 16; ++t) {
        if (t + 3 < 16) WLD(t + 3)
        __builtin_amdgcn_sched_barrier(0);
        const f32x4 z4 = Z[t], w4 = W[t], nb4 = NB[t], k4 = K[t], r4 = R[t]; const float vv = V[t]; const f32x2 bk2 = BK[t];
        const f32x2 zlo = {z4[0], z4[1]}, zhi = {z4[2], z4[3]}, wlo = {w4[0], w4[1]}, whi = {w4[2], w4[3]};
        const f32x2 nblo = {nb4[0], nb4[1]}, nbhi = {nb4[2], nb4[3]}, klo = {k4[0], k4[1]}, khi = {k4[2], k4[3]}, rlo = {r4[0], r4[1]}, rhi = {r4[2], r4[3]};
        f32x2 pp = slo * zlo; pp = shi * zhi + pp;
        float pr = pp[0] + pp[1];
        const f32x2 vklo = klo * vv, vkhi = khi * vv;
        const f32x2 tlo = nblo * sa + vklo, thi = nbhi * sa + vkhi;
        slo = slo * wlo + tlo; shi = shi * whi + thi;
        const float cnext = sa * bk2[0] + vv * bk2[1];
        pr = row16_sum(pr);
        if (t > 0) { const float yr = row16_sum(yprev); ykeep = ((lane & 15) == t - 1) ? yr : ykeep; }
        f32x2 qq = slo * rlo; qq = shi * rhi + qq;
        yprev = qq[0] + qq[1];
        sa = pr + cnext;
      }
      { const float yr = row16_sum(yprev); ykeep = ((lane & 15) == 15) ? yr : ykeep; }
      yraw[(size_t)(row0 + c * 16 + (lane & 15)) * 1024 + hd * 64 + myrow] = f2bf(ykeep);
      LBAR();
    }
    st = (f32x4){slo[0], slo[1], shi[0], shi[1]};
    *(f32x4*)(p.out + OUT_WKV + (((size_t)stream * 16 + hd) * 64 + myrow) * 64 + c4) = st;
  }
}

#define XB_TMO      128
#define XB_XCNT(j)  (256  + 64 * (j))
#define XB_XSUB(j)  (1280 + 64 * (j))
#define XB_XGEN(j)  (2304 + 64 * (j))
#define XB_TOP      3328
#define XB_TOPGEN   3392
#define XCD_BAR_WORDS 3456
#define XB_SPIN_CAP (1u << 20)
#define LAS3 __attribute__((address_space(3)))
DEV unsigned xb_ld(unsigned* p) { return __hip_atomic_load(p, __ATOMIC_RELAXED, __HIP_MEMORY_SCOPE_AGENT); }
DEV unsigned xb_add(unsigned* p, unsigned v) { return __hip_atomic_fetch_add(p, v, __ATOMIC_RELAXED, __HIP_MEMORY_SCOPE_AGENT); }
DEV unsigned xb_xcc_id() { return (unsigned)__builtin_amdgcn_s_getreg((3 << 11) | 20) & 0xFu; }
#define XB_SPIN(cond, bar) do { unsigned _sp = 0; while (cond) { __builtin_amdgcn_s_sleep(1); \
    if ((++_sp & 255u) == 0u) { if (xb_ld(&(bar)[XB_TMO])) break; if (_sp > XB_SPIN_CAP) { atomicAdd(&(bar)[XB_TMO], 1u); break; } } } } while (0)
struct XcdBarrier { unsigned* bar; unsigned x; volatile LAS3 unsigned* st; };
DEV XcdBarrier xcd_barrier_post(unsigned* bar, volatile LAS3 unsigned* st) {
  XcdBarrier b; b.bar = bar; b.x = xb_xcc_id(); b.st = st;
  if (threadIdx.x == 0) (void)xb_add(&bar[XB_XCNT(b.x)], 1u);
  return b;
}
DEV void xcd_barrier_complete(unsigned* bar, unsigned x, unsigned& nloc, unsigned& nx) {
  const unsigned G = gridDim.x;
  unsigned sum, cnt, mine, sp = 0u;
  for (;;) {
    sum = 0u; cnt = 0u; mine = 0u;
#pragma unroll
    for (unsigned j = 0; j < 16; ++j) { const unsigned c = xb_ld(&bar[XB_XCNT(j)]); sum += c; cnt += (c > 0u) ? 1u : 0u; mine = (j == x) ? c : mine; }
    if (sum == G) break;
    __builtin_amdgcn_s_sleep(1);
    if ((++sp & 255u) == 0u) { if (xb_ld(&bar[XB_TMO])) break; if (sp > XB_SPIN_CAP) { atomicAdd(&bar[XB_TMO], 1u); break; } }
  }
  nloc = mine > 0u ? mine : 1u; nx = cnt > 0u ? cnt : 1u;
}
DEV void xcd_barrier(const XcdBarrier& b) {
  asm volatile("s_waitcnt vmcnt(0)" ::: "memory");
  __syncthreads();
  if (threadIdx.x == 0) {
    unsigned* bar = b.bar;
    __builtin_amdgcn_s_waitcnt(0);
    unsigned nloc = b.st[0], nx = b.st[1];
    if (nloc == 0u) { xcd_barrier_complete(bar, b.x, nloc, nx); b.st[0] = nloc; b.st[1] = nx; }
    const unsigned old = xb_add(&bar[XB_XSUB(b.x)], 1u);
    const unsigned gen = old / nloc;
    if (old + 1u == (gen + 1u) * nloc) {
      __builtin_amdgcn_fence(__ATOMIC_RELEASE, "agent");
      asm volatile("s_waitcnt vmcnt(0)" ::: "memory");
      const unsigned og = xb_add(&bar[XB_TOP], 1u);
      const unsigned tg = og / nx;
      if (og + 1u == (tg + 1u) * nx) xb_add(&bar[XB_TOPGEN], 1u);
      else XB_SPIN(xb_ld(&bar[XB_TOPGEN]) == tg, bar);
      __builtin_amdgcn_fence(__ATOMIC_ACQUIRE, "agent");
      xb_add(&bar[XB_XGEN(b.x)], 1u);
      asm volatile("s_waitcnt vmcnt(0)" ::: "memory");
    } else {
      XB_SPIN(xb_ld(&bar[XB_XGEN(b.x)]) == gen, bar);
      __builtin_amdgcn_fence(__ATOMIC_ACQUIRE, "agent");
      asm volatile("s_waitcnt vmcnt(0)" ::: "memory");
    }
  }
  __syncthreads();
}

__global__ void __launch_bounds__(NTHREADS, 2) mega(P p) {
  cg::grid_group grid = cg::this_grid();
  __shared__ __attribute__((aligned(16))) char smem[SMEM_BYTES];
  __shared__ int s_item;
  __shared__ __attribute__((aligned(16))) unsigned xb_st[4];
  const int tid = otid(), lane = tid & 63, wid = tid >> 6;
  const int G = gridDim.x, bid = blockIdx.x;
  char* ws = p.ws;
  const float* mod0 = (const float*)(ws + O_MOD);
  const float* mod1 = mod0 + 9 * 6144;
  float* xbuf = p.out + OUT_Y;
  bf16_t* R1 = (bf16_t*)(ws + O_R1);
  unsigned* bar = (unsigned*)(ws + O_BAR);
  if (threadIdx.x < 4) xb_st[threadIdx.x] = 0u;
  __syncthreads();
  const XcdBarrier xb = xcd_barrier_post(bar, (volatile LAS3 unsigned*)xb_st);

  phase0(p, smem);
  grid.sync();
  rownorm_phase(p, nullptr, p.in[13], 0, 0, 1, R1, 0);
  xcd_barrier(xb);
  {
    bf16_t* proj = (bf16_t*)(ws + O_PROJ); float* pab = (float*)(ws + O_PAB); float* conv = p.out + OUT_CONV;
    auto epi = [&](int row, int col, const f32x4& v, const PV& pv) {
      if (col < NPROJ) {
        st_bf4(proj + (size_t)row * NPROJ + col, v);
        if (col < 1536) {
          if (row >= TP - 3 && row < TP) *(f32x4*)(conv + (size_t)(row - (TP - 3)) * 1536 + col) = v;
          else if (row >= TP && ((row - TP) & 15) >= 13) *(f32x4*)(conv + ((size_t)(1 + ((row - TP) >> 4)) * 3 + (((row - TP) & 15) - 13)) * 1536 + col) = v;
        }
      } else if (col < NPROJ + 12) *(f32x4*)(pab + (size_t)row * 16 + (col - NPROJ)) = v;
    };
    for (int t = bid; t < 128 * 15 + 58; t += G) {
      if (t < 128 * 15) {
        const int mt = t / 15, j = t % 15;
        if (j < 14) gemm_tile<0, 256>(R1, D, (const bf16_t*)(ws + O_WIN), D, D, mt * 128, j * 256, smem, nullptr, epi);
        else gemm_tile<0, 128>(R1, D, (const bf16_t*)(ws + O_WIN), D, D, mt * 128, 3584, smem, nullptr, epi);
      } else gemm_tile<0, 64>(R1, D, (const bf16_t*)(ws + O_WIN), D, D, 128 * 128, (t - 128 * 15) * 64, smem, nullptr, epi);
    }
  }
  xcd_barrier(xb);
  for (int t = bid; t < 129 + GITEMS; t += G) {
#if PM & 4
    if (t < GITEMS) gdn_prep_item(p, t, smem); else fox_prep_tile(p, t - GITEMS, smem);
#endif
  }
  xcd_barrier(xb);
  {
  #if PM & 1
    if (bid < 72) gdn_scan_item(p, bid, smem);
#endif
    unsigned* ctr = (unsigned*)(ws + O_CTR);
    for (;;) {
      __syncthreads();
      if (tid == 0) s_item = (int)atomicAdd(ctr, 1u);
      __syncthreads();
      const int it = s_item;
      if (it >= 32 + 512) break;
#if PM & 2
      fox_attn_item(p, it, smem);
#endif
    }
  }
  xcd_barrier(xb);
  {
    const float* oraw = (const float*)(ws + O_ORAW); const bf16_t* proj = (const bf16_t*)(ws + O_PROJ); const float* on = p.in[19];
    for (int row = bid * 4 + wid; row < T; row += G * 4) {
#pragma unroll
      for (int hd = 0; hd < 4; ++hd) {
        const int c = hd * 128 + lane * 2;
        const f32x2 o = *(const f32x2*)(oraw + (size_t)row * 512 + c);
        const float ss = wave_sum(o[0] * o[0] + o[1] * o[1]); const float rs = rsqrtf(ss * (1.f / 128.f) + 1e-6f);
        const unsigned zu = *(const unsigned*)(proj + (size_t)row * NPROJ + 1536 + c);
        *(unsigned*)(R1 + (size_t)row * D + c) = pk2(o[0] * rs * on[lane * 2] * siluf_(bflo(zu)), o[1] * rs * on[lane * 2 + 1] * siluf_(bfhi(zu)));
      }
    }
  }
  xcd_barrier(xb);
  {
    auto pre = [&](int row, int col) { PV o; o.a = *(const f32x4*)(xin_row(p, row) + col); o.b = *(const f32x4*)(mod0 + stream_of(row) * 6144 + 2 * 1024 + col); return o; };
    auto epi = [&](int row, int col, const f32x4& v, const PV& pv) { *(f32x4*)(xbuf + (size_t)row * D + col) = pv.a + pv.b * v; };
    for (int t = bid; t < 512 + 16; t += G) {
      if (t < 512) gemm_tile<0, 256>(R1, D, (const bf16_t*)(ws + O_WOUT), D, D, (t >> 2) * 128, (t & 3) * 256, smem, nullptr, epi, pre);
      else gemm_tile<0, 64>(R1, D, (const bf16_t*)(ws + O_WOUT), D, D, 128 * 128, (t - 512) * 64, smem, nullptr, epi, pre);
    }
  }
  xcd_barrier(xb);
  rownorm_phase(p, xbuf, p.in[14], 0, 3, 4, R1, 0);
  xcd_barrier(xb);
  {
    bf16_t* hid = (bf16_t*)(ws + O_HID);
    auto epi = [&](int row, int col, const f32x4& v, const PV& pv) { f32x4 o; for (int e = 0; e < 4; ++e) { const float rl = fmaxf(v[e], 0.f); o[e] = rl * rl; } st_bf4(hid + (size_t)row * DFF + col, o); };
    for (int t = bid; t < 2048 + 64; t += G) {
      if (t < 2048) gemm_tile<0, 256>(R1, D, (const bf16_t*)(ws + O_FF1_0), D, D, (t >> 4) * 128, (t & 15) * 256, smem, nullptr, epi);
      else gemm_tile<0, 64>(R1, D, (const bf16_t*)(ws + O_FF1_0), D, D, 128 * 128, (t - 2048) * 64, smem, nullptr, epi);
    }
  }
  xcd_barrier(xb);
  {
    auto pre = [&](int row, int col) { PV o; o.a = *(const f32x4*)(xbuf + (size_t)row * D + col); o.b = *(const f32x4*)(mod0 + stream_of(row) * 6144 + 5 * 1024 + col); return o; };
    auto epi = [&](int row, int col, const f32x4& v, const PV& pv) { *(f32x4*)(xbuf + (size_t)row * D + col) = pv.a + pv.b * v; };
    for (int t = bid; t < 512 + 16; t += G) {
      if (t < 512) gemm_tile<0, 256>((const bf16_t*)(ws + O_HID), DFF, (const bf16_t*)(ws + O_FF2_0), DFF, DFF, (t >> 2) * 128, (t & 3) * 256, smem, nullptr, epi, pre);
      else gemm_tile<0, 64>((const bf16_t*)(ws + O_HID), DFF, (const bf16_t*)(ws + O_FF2_0), DFF, DFF, 128 * 128, (t - 512) * 64, smem, nullptr, epi, pre);
    }
  }
  xcd_barrier(xb);
  rownorm_phase(p, xbuf, p.in[28], 1, 0, 1, R1, 1);
  xcd_barrier(xb);
  {
    bf16_t* rkvb = (bf16_t*)(ws + O_RKVB); bf16_t* lw = (bf16_t*)(ws + O_LW); bf16_t* la = (bf16_t*)(ws + O_LA); bf16_t* lg = (bf16_t*)(ws + O_LG);
    auto epi_rkv = [&](int row, int col, const f32x4& v, const PV& pv) { st_bf4(rkvb + (size_t)row * 3072 + col, v); };
    for (int t = bid; t < 128 * 16 + 56; t += G) {
      int m0, n0, kind;
      if (t < 128 * 16) { const int j = t & 15; m0 = (t >> 4) * 128; if (j < 12) { n0 = j * 256; kind = 0; } else { n0 = 3072 + (j - 12) * 128; kind = 1; } }
      else { m0 = 128 * 128; n0 = (t - 128 * 16) * 64; kind = 2; }
      if (n0 < 3072) {
        const int g = n0 >> 10; const int mui = g == 0 ? 0 : (g == 1 ? 2 : 3);
        if (kind == 0) gemm_tile<1, 256>(R1, D, (const bf16_t*)(ws + O_RKV), D, D, m0, n0, smem, p.in[30] + mui * 1024, epi_rkv);
        else gemm_tile<1, 64>(R1, D, (const bf16_t*)(ws + O_RKV), D, D, m0, n0, smem, p.in[30] + mui * 1024, epi_rkv);
      } else {
        const int nt = 24 + ((n0 - 3072) >> 7);
        const int mui = nt == 24 ? 1 : (nt == 25 ? 4 : 5);
        auto epi = [&](int row, int col, const f32x4& v, const PV& pv) {
          if (nt == 24) { if (col < 64) { const f32x4 o = {tanhf(v[0]), tanhf(v[1]), tanhf(v[2]), tanhf(v[3])}; st_bf4(lw + (size_t)row * 64 + col, o); } }
          else if (nt == 25) { const int c = col - 128; if (c < 64) st_bf4(la + (size_t)row * 64 + c, v); }
          else { const int c = col - 256; if (c < 192) { f32x4 o = {0.f, 0.f, 0.f, 0.f}; if (c < 160) o = (f32x4){sigmoidf_(v[0]), sigmoidf_(v[1]), sigmoidf_(v[2]), sigmoidf_(v[3])}; st_bf4(lg + (size_t)row * 192 + c, o); } }
        };
        if (kind == 1) gemm_tile<1, 128>(R1, D, (const bf16_t*)(ws + O_LORA1), D, D, m0, n0 - 3072, smem, p.in[30] + mui * 1024, epi);
        else gemm_tile<1, 64>(R1, D, (const bf16_t*)(ws + O_LORA1), D, D, m0, n0 - 3072, smem, p.in[30] + mui * 1024, epi);
      }
    }
  }
  xcd_barrier(xb);
  {
    float* dec = (float*)(ws + O_DEC); bf16_t* abuf = (bf16_t*)(ws + O_AB); bf16_t* gate = (bf16_t*)(ws + O_GATE);
    const float* w0 = p.in[34]; const float* a0 = p.in[37];
    for (int t = bid; t < 129 * 24; t += G) {
      const int mt = t / 24, nt = t % 24, g = nt >> 3, n0 = (nt & 7) * 128;
      if (g == 0) {
        auto pre = [&](int row, int col) { PV o; o.a = *(const f32x4*)(w0 + col); o.b = o.a; return o; };
        auto epi = [&](int row, int col, const f32x4& v, const PV& pv) { f32x4 o; for (int e = 0; e < 4; ++e) { const float wl = -softplusf_(-(pv.a[e] + v[e])) - 0.5f; o[e] = __expf(-__expf(wl)); } *(f32x4*)(dec + (size_t)row * D + col) = o; };
        gemm_tile<0>((const bf16_t*)(ws + O_LW), 64, (const bf16_t*)(ws + O_W2), 64, 64, mt * 128, n0, smem, nullptr, epi, pre);
      } else if (g == 1) {
        auto pre = [&](int row, int col) { PV o; o.a = *(const f32x4*)(a0 + col); o.b = o.a; return o; };
        auto epi = [&](int row, int col, const f32x4& v, const PV& pv) { f32x4 o; for (int e = 0; e < 4; ++e) o[e] = sigmoidf_(pv.a[e] + v[e]); st_bf4(abuf + (size_t)row * D + col, o); };
        gemm_tile<0>((const bf16_t*)(ws + O_LA), 64, (const bf16_t*)(ws + O_A2), 64, 64, mt * 128, n0, smem, nullptr, epi, pre);
      } else {
        auto epi = [&](int row, int col, const f32x4& v, const PV& pv) { st_bf4(gate + (size_t)row * D + col, v); };
        gemm_tile<0>((const bf16_t*)(ws + O_LG), 192, (const bf16_t*)(ws + O_G2), 192, 192, mt * 128, n0, smem, nullptr, epi);
      }
    }
  }
  xcd_barrier(xb);
#if PM & 8
  if (G > 256) {
    if (bid < 256) wkv_scan_item(p, bid, smem);
    else for (int it = 256 + (bid - 256); it < 256 + 2048; it += G - 256) wkv_scan_item(p, it, smem);
  } else {
    for (int it = bid; it < 256 + 2048; it += G) wkv_scan_item(p, it, smem);
  }
#endif
  xcd_barrier(xb);
  {
    const bf16_t* yraw = R1; const bf16_t* rkvb = (const bf16_t*)(ws + O_RKVB); const bf16_t* abuf = (const bf16_t*)(ws + O_AB);
    const bf16_t* gate = (const bf16_t*)(ws + O_GATE); bf16_t* ybf = (bf16_t*)(ws + O_DEC);
    const float* ka = p.in[43]; const float* rk = p.in[44]; const float* lnw = p.in[45]; const float* lnb = p.in[46];
    for (int row = bid * 4 + wid; row < T; row += G * 4) {
      const int c0 = lane * 16;
      u32x4 yv[2], rv[2], kv[2], vv[2], av[2], gv[2];
#pragma unroll
      for (int q = 0; q < 2; ++q) {
        yv[q] = *(const u32x4*)(yraw + (size_t)row * D + c0 + 8 * q);
        rv[q] = *(const u32x4*)(rkvb + (size_t)row * 3072 + c0 + 8 * q);
        kv[q] = *(const u32x4*)(rkvb + (size_t)row * 3072 + 1024 + c0 + 8 * q);
        vv[q] = *(const u32x4*)(rkvb + (size_t)row * 3072 + 2048 + c0 + 8 * q);
        av[q] = *(const u32x4*)(abuf + (size_t)row * D + c0 + 8 * q);
        gv[q] = *(const u32x4*)(gate + (size_t)row * D + c0 + 8 * q);
      }
      float y[16]; float sum = 0.f, bs = 0.f;
#pragma unroll
      for (int e = 0; e < 16; ++e) {
        const unsigned yu = yv[e >> 3][(e >> 1) & 3], ru = rv[e >> 3][(e >> 1) & 3], ku = kv[e >> 3][(e >> 1) & 3], au = av[e >> 3][(e >> 1) & 3];
        const float yy = (e & 1) ? bfhi(yu) : bflo(yu), rr = (e & 1) ? bfhi(ru) : bflo(ru), kk = (e & 1) ? bfhi(ku) : bflo(ku), aa = (e & 1) ? bfhi(au) : bflo(au);
        y[e] = yy; sum += yy;
        const float kp = kk * (1.f + (aa - 1.f) * ka[c0 + e]);
        bs += rr * kp * rk[c0 + e];
      }
      sum = dpp_add(sum, 0); sum = dpp_add(sum, 1);
      bs = dpp_add(bs, 0); bs = dpp_add(bs, 1);
      const float mean = sum * (1.f / 64.f);
      float vs_ = 0.f;
#pragma unroll
      for (int e = 0; e < 16; ++e) { const float d = y[e] - mean; vs_ += d * d; }
      vs_ = dpp_add(vs_, 0); vs_ = dpp_add(vs_, 1);
      const float rstd = rsqrtf(vs_ * (1.f / 64.f) + 64e-5f);
      u32x4 ov[2];
#pragma unroll
      for (int e = 0; e < 16; e += 2) {
        float o2[2];
#pragma unroll
        for (int f = 0; f < 2; ++f) {
          const int ee = e + f;
          const unsigned vu = vv[ee >> 3][(ee >> 1) & 3], gu = gv[ee >> 3][(ee >> 1) & 3];
          const float vvv = (ee & 1) ? bfhi(vu) : bflo(vu), gg = (ee & 1) ? bfhi(gu) : bflo(gu);
          const float yn = (y[ee] - mean) * rstd * lnw[c0 + ee] + lnb[c0 + ee];
          o2[f] = (yn + bs * vvv) * gg;
        }
        ov[e >> 3][(e >> 1) & 3] = pk2(o2[0], o2[1]);
      }
      *(u32x4*)(ybf + (size_t)row * D + c0) = ov[0];
      *(u32x4*)(ybf + (size_t)row * D + c0 + 8) = ov[1];
    }
  }
  xcd_barrier(xb);
  {
    auto pre = [&](int row, int col) { PV o; o.a = *(const f32x4*)(xbuf + (size_t)row * D + col); o.b = *(const f32x4*)(mod1 + stream_of(row) * 6144 + 2 * 1024 + col); return o; };
    auto epi = [&](int row, int col, const f32x4& v, const PV& pv) { *(f32x4*)(xbuf + (size_t)row * D + col) = pv.a + pv.b * v; };
    for (int t = bid; t < 512 + 16; t += G) {
      if (t < 512) gemm_tile<0, 256>((const bf16_t*)(ws + O_DEC), D, (const bf16_t*)(ws + O_WO), D, D, (t >> 2) * 128, (t & 3) * 256, smem, nullptr, epi, pre);
      else gemm_tile<0, 64>((const bf16_t*)(ws + O_DEC), D, (const bf16_t*)(ws + O_WO), D, D, 128 * 128, (t - 512) * 64, smem, nullptr, epi, pre);
    }
  }
  xcd_barrier(xb);
  rownorm_phase(p, xbuf, p.in[29], 1, 3, 4, R1, 0);
  xcd_barrier(xb);
  {
    bf16_t* hid = (bf16_t*)(ws + O_HID);
    auto epi = [&](int row, int col, const f32x4& v, const PV& pv) { f32x4 o; for (int e = 0; e < 4; ++e) { const float rl = fmaxf(v[e], 0.f); o[e] = rl * rl; } st_bf4(hid + (size_t)row * DFF + col, o); };
    for (int t = bid; t < 2048 + 64; t += G) {
      if (t < 2048) gemm_tile<0, 256>(R1, D, (const bf16_t*)(ws + O_FF1_1), D, D, (t >> 4) * 128, (t & 15) * 256, smem, nullptr, epi);
      else gemm_tile<0, 64>(R1, D, (const bf16_t*)(ws + O_FF1_1), D, D, 128 * 128, (t - 2048) * 64, smem, nullptr, epi);
    }
  }
  xcd_barrier(xb);
  {
    auto pre = [&](int row, int col) { PV o; o.a = *(const f32x4*)(xbuf + (size_t)row * D + col); o.b = *(const f32x4*)(mod1 + stream_of(row) * 6144 + 5 * 1024 + col); return o; };
    auto epi = [&](int row, int col, const f32x4& v, const PV& pv) { *(f32x4*)(xbuf + (size_t)row * D + col) = pv.a + pv.b * v; };
    for (int t = bid; t < 512 + 16; t += G) {
      if (t < 512) gemm_tile<0, 256>((const bf16_t*)(ws + O_HID), DFF, (const bf16_t*)(ws + O_FF2_1), DFF, DFF, (t >> 2) * 128, (t & 3) * 256, smem, nullptr, epi, pre);
      else gemm_tile<0, 64>((const bf16_t*)(ws + O_HID), DFF, (const bf16_t*)(ws + O_FF2_1), DFF, DFF, 128 * 128, (t - 512) * 64, smem, nullptr, epi, pre);
    }
  }
}

extern "C" void kernel_launch(void* const* d_in, const int* in_sizes, int n_in, void* d_out, int out_size, void* d_ws, size_t ws_size,
                              hipStream_t stream) {
  static int grid_blocks = 0;
  if (!grid_blocks) {
    int dev = 0, cus = 0, per_cu = 0;
    hipGetDevice(&dev);
    hipDeviceGetAttribute(&cus, hipDeviceAttributeMultiprocessorCount, dev);
    hipOccupancyMaxActiveBlocksPerMultiprocessor(&per_cu, mega, NTHREADS, 0);
    if (per_cu > 2) per_cu = 2;
    grid_blocks = cus * per_cu;
    if (ws_size < WS_NEED) fprintf(stderr, "workspace too small: %zu < %zu\n", ws_size, (size_t)WS_NEED);
  }
  P p{};
  for (int i = 0; i < 50; ++i) p.in[i] = (const float*)d_in[i];
  p.out = (float*)d_out;
  p.ws = (char*)d_ws;
  (void)hipMemsetAsync((char*)d_ws + O_BAR, 0, 16384, stream);
  void* args[] = {&p};
  hipError_t e = hipLaunchCooperativeKernel((void*)mega, dim3(grid_blocks), dim3(NTHREADS), args, 0, stream);
  if (e != hipSuccess) fprintf(stderr, "cooperative launch failed: %s (grid %d)\n", hipGetErrorString(e), grid_blocks);
}
```

```cpp
#include <hip/hip_runtime.h>
#include <hip/hip_cooperative_groups.h>
#include <cstdio>
#include <cstdint>
namespace cg = cooperative_groups;
#ifndef PM
#define PM 255
#endif

#define DEV __device__ __forceinline__
typedef unsigned short bf16_t;
typedef short bf16x8 __attribute__((ext_vector_type(8)));
typedef float f32x2 __attribute__((ext_vector_type(2)));
typedef float f32x4 __attribute__((ext_vector_type(4)));
typedef float f32x16 __attribute__((ext_vector_type(16)));
typedef unsigned u32x2 __attribute__((ext_vector_type(2)));
typedef unsigned u32x4 __attribute__((ext_vector_type(4)));
typedef __bf16 bf2_t __attribute__((ext_vector_type(2)));

constexpr int D = 1024, TP = 16384, TS = 128, T = TP + TS, NS = 9, DFF = 4096;
constexpr int NWIN = 3712;
constexpr int NPROJ = 3584;
constexpr float LOG2E = 1.4426950408889634f;
constexpr int NTHREADS = 256;
constexpr int SMEM_BYTES = 57344 + 1024;

constexpr size_t OUT_Y = 0;
constexpr size_t OUT_CONV = OUT_Y + (size_t)T * D;
constexpr size_t OUT_DELTA = OUT_CONV + 9ull * 3 * 1536;
constexpr size_t OUT_FK = OUT_DELTA + 9ull * 4 * 128 * 128;
constexpr size_t OUT_FV = OUT_FK + (size_t)T * 512;
constexpr size_t OUT_LOGF = OUT_FV + (size_t)T * 512;
constexpr size_t OUT_SHIFT = OUT_LOGF + (size_t)T * 4;
constexpr size_t OUT_WKV = OUT_SHIFT + 9ull * 1024;
constexpr size_t OUT_TOTAL = OUT_WKV + 9ull * 16 * 64 * 64;

constexpr size_t al256(size_t x) { return (x + 255) & ~(size_t)255; }
constexpr size_t O_WIN = 0;
constexpr size_t O_WOUT = O_WIN + (size_t)NWIN * 1024 * 2;
constexpr size_t O_FF1_0 = O_WOUT + 1024ull * 1024 * 2;
constexpr size_t O_FF2_0 = O_FF1_0 + 4096ull * 1024 * 2;
constexpr size_t O_RKV = O_FF2_0 + 4096ull * 1024 * 2;
constexpr size_t O_LORA1 = O_RKV + 3072ull * 1024 * 2;
constexpr size_t O_W2 = O_LORA1 + 512ull * 1024 * 2;
constexpr size_t O_A2 = O_W2 + 1024ull * 64 * 2;
constexpr size_t O_G2 = O_A2 + 1024ull * 64 * 2;
constexpr size_t O_WO = O_G2 + 1024ull * 192 * 2;
constexpr size_t O_FF1_1 = O_WO + 1024ull * 1024 * 2;
constexpr size_t O_FF2_1 = O_FF1_1 + 4096ull * 1024 * 2;
constexpr size_t O_MOD = O_FF2_1 + 4096ull * 1024 * 2;
constexpr size_t O_CTR = O_MOD + 2ull * 9 * 6144 * 4;
constexpr size_t O_TOT = O_CTR + 256;
constexpr size_t O_CL = al256(O_TOT + 129 * 16);
constexpr size_t O_PAB = al256(O_CL + (size_t)T * 16);
constexpr size_t O_GL = al256(O_PAB + (size_t)T * 64);
constexpr size_t O_BAR = al256(O_GL + 8192);
constexpr size_t O_R1 = al256(O_BAR + 16384);
constexpr size_t R1_BYTES = 34ull << 20;
constexpr size_t O_R2 = O_R1 + R1_BYTES;
constexpr size_t O_PROJ = O_R2;
constexpr size_t O_GIMG = al256(O_PROJ + (size_t)T * NPROJ * 2);
constexpr int GITEMS = 264 * 4;
constexpr size_t GIMG_BYTES = 73728;
constexpr size_t O_ORAW = al256(O_GIMG + (size_t)GITEMS * GIMG_BYTES);
constexpr size_t L0_END = O_ORAW + (size_t)T * 512 * 4;
constexpr size_t O_HID = O_R2;
constexpr size_t O_RKVB = O_R2;
constexpr size_t O_LW = al256(O_RKVB + (size_t)T * 3072 * 2);
constexpr size_t O_LA = al256(O_LW + (size_t)T * 64 * 2);
constexpr size_t O_LG = al256(O_LA + (size_t)T * 64 * 2);
constexpr size_t O_DEC = al256(O_LG + (size_t)T * 192 * 2);
constexpr size_t O_AB = al256(O_DEC + (size_t)T * 1024 * 4);
constexpr size_t O_GATE = al256(O_AB + (size_t)T * 1024 * 2);
constexpr size_t L1_END = O_GATE + (size_t)T * 1024 * 2;
constexpr size_t HID_END = O_HID + (size_t)T * 4096 * 2;
constexpr size_t WS_NEED = (L0_END > L1_END ? (L0_END > HID_END ? L0_END : HID_END) : (L1_END > HID_END ? L1_END : HID_END));

struct P { const float* in[50]; float* out; char* ws; };

DEV unsigned pk2(float a, float b) { f32x2 v = {a, b}; bf2_t r = __builtin_convertvector(v, bf2_t); return __builtin_bit_cast(unsigned, r); }
DEV bf16_t f2bf(float a) { return (bf16_t)(pk2(a, 0.f) & 0xffffu); }
DEV void st_bf4(bf16_t* p, const f32x4& v) { u32x2 o; o[0] = pk2(v[0], v[1]); o[1] = pk2(v[2], v[3]); *(u32x2*)p = o; }
DEV float bf2f(bf16_t b) { return __uint_as_float(((unsigned)b) << 16); }
DEV float bflo(unsigned u) { return __uint_as_float(u << 16); }
DEV float bfhi(unsigned u) { return __uint_as_float(u & 0xffff0000u); }
DEV int otid() { int t = threadIdx.x; asm volatile("" : "+v"(t)); return t; }
DEV float dpp_add(float x, const int ctrl_sel) {
  int xi = __float_as_int(x), yi;
  if (ctrl_sel == 0) yi = __builtin_amdgcn_update_dpp(0, xi, 0xB1, 0xF, 0xF, true);
  else if (ctrl_sel == 1) yi = __builtin_amdgcn_update_dpp(0, xi, 0x4E, 0xF, 0xF, true);
  else if (ctrl_sel == 2) yi = __builtin_amdgcn_update_dpp(0, xi, 0x141, 0xF, 0xF, true);
  else yi = __builtin_amdgcn_update_dpp(0, xi, 0x140, 0xF, 0xF, true);
  return x + __int_as_float(yi);
}
DEV float row16_sum(float x) { x = dpp_add(x, 0); x = dpp_add(x, 1); x = dpp_add(x, 2); x = dpp_add(x, 3); return x; }
DEV float wave_sum(float v) {
  v = row16_sum(v);
  const int vi = __float_as_int(v);
  const float a = __int_as_float(__builtin_amdgcn_readlane(vi, 0)), b = __int_as_float(__builtin_amdgcn_readlane(vi, 16));
  const float c = __int_as_float(__builtin_amdgcn_readlane(vi, 32)), d = __int_as_float(__builtin_amdgcn_readlane(vi, 48));
  return (a + b) + (c + d);
}
DEV float sigmoidf_(float x) { return 1.f / (1.f + __expf(-x)); }
DEV float siluf_(float x) { return x / (1.f + __expf(-x)); }
DEV float softplusf_(float x) { return x > 20.f ? x : log1pf(__expf(x)); }
DEV float logsigmoidf_(float x) { return fminf(x, 0.f) - log1pf(__expf(-fabsf(x))); }
DEV int stream_of(int row) { return row < TP ? 0 : 1 + ((row - TP) >> 4); }
DEV int perm16(int o) { return 8 * ((o >> 2) & 1) + (o & 3) + 4 * (o >> 3); }
DEV int crow(int i, int h) { return (i & 3) + 8 * (i >> 2) + 4 * h; }
DEV bf16x8 pack8(const f32x16& x, const int s) {
  u32x4 p;
  p[0] = pk2(x[8 * s + 0], x[8 * s + 1]); p[1] = pk2(x[8 * s + 2], x[8 * s + 3]);
  p[2] = pk2(x[8 * s + 4], x[8 * s + 5]); p[3] = pk2(x[8 * s + 6], x[8 * s + 7]);
  return __builtin_bit_cast(bf16x8, p);
}
#define LBAR() asm volatile("s_waitcnt lgkmcnt(0)\n\ts_barrier" ::: "memory")
#define MFMA32(a, b, c) __builtin_amdgcn_mfma_f32_32x32x16_bf16((a), (b), (c), 0, 0, 0)
DEV const float* xin_row(const P& p, int row) { return row < TP ? p.in[0] + (size_t)row * D : p.in[1] + (size_t)(row - TP) * D; }

constexpr int LDT = 144;

template <int MIX, int BN>
DEV void gemm_gload(const bf16_t* A, int lda, const bf16_t* B, int ldb, int m0, int n0, int k0, int tid,
                    u32x4 (&ra)[4], u32x4 (&rp)[4], f32x4 (&rm)[2], u32x4 (&rb)[BN / 32], const float* mu) {
  const int kc = tid & 7, r0 = tid >> 3;
#pragma unroll
  for (int i = 0; i < 4; ++i) {
    const int row = r0 + 32 * i;
    if (!MIX) {
      ra[i] = *(const u32x4*)(A + (size_t)(m0 + row) * lda + k0 + kc * 8);
    } else {
      const int t = m0 + row;
      const int pr = t < TP ? t + 1 : t + 2 + ((t - TP) >> 4);
      ra[i] = *(const u32x4*)(A + (size_t)pr * D + k0 + kc * 8);
      rp[i] = *(const u32x4*)(A + (size_t)(pr - 1) * D + k0 + kc * 8);
    }
  }
#pragma unroll
  for (int i = 0; i < BN / 32; ++i) rb[i] = *(const u32x4*)(B + (size_t)(n0 + r0 + 32 * i) * ldb + k0 + kc * 8);
  if (MIX) { rm[0] = *(const f32x4*)(mu + k0 + kc * 8); rm[1] = *(const f32x4*)(mu + k0 + kc * 8 + 4); }
}
template <int MIX, int BN>
DEV void gemm_lstore(char* sA, char* sB, int tid, const u32x4 (&ra)[4], const u32x4 (&rp)[4], const f32x4 (&rm)[2], const u32x4 (&rb)[BN / 32]) {
  const int kc = tid & 7, r0 = tid >> 3;
#pragma unroll
  for (int i = 0; i < 4; ++i) {
    u32x4 o = ra[i];
    if (MIX) {
#pragma unroll
      for (int e = 0; e < 4; ++e) {
        const float h0 = bflo(ra[i][e]), h1 = bfhi(ra[i][e]), p0 = bflo(rp[i][e]), p1 = bfhi(rp[i][e]);
        const float ma = (e < 2) ? rm[0][2 * e] : rm[1][2 * e - 4], mb = (e < 2) ? rm[0][2 * e + 1] : rm[1][2 * e - 3];
        o[e] = pk2(h0 + (p0 - h0) * ma, h1 + (p1 - h1) * mb);
      }
    }
    *(u32x4*)(sA + (r0 + 32 * i) * LDT + kc * 16) = o;
  }
#pragma unroll
  for (int i = 0; i < BN / 32; ++i) *(u32x4*)(sB + (r0 + 32 * i) * LDT + kc * 16) = rb[i];
}

struct PV { f32x4 a, b; };
struct NoPre { DEV PV operator()(int, int) const { PV z; z.a = (f32x4){0.f, 0.f, 0.f, 0.f}; z.b = z.a; return z; } };
template <int MIX, int BN = 128, class Epi, class Pre = NoPre>
DEV void gemm_tile(const bf16_t* A, int lda, const bf16_t* B, int ldb, int K, int m0, int n0, char* smem, const float* mu, Epi epi, Pre pre = Pre()) {
  constexpr int PD = BN == 256 ? 1 : (MIX ? 2 : 3);
  constexpr int NI = BN / 64;
  char* sA = smem; char* sB = smem + 128 * LDT;
  const int tid = otid(), lane = tid & 63, wid = tid >> 6, wr = wid >> 1, wc = wid & 1, h = lane >> 5, r = lane & 31;
  f32x16 acc[2][NI];
#pragma unroll
  for (int a = 0; a < 2; ++a)
#pragma unroll
    for (int b = 0; b < NI; ++b)
#pragma unroll
      for (int i = 0; i < 16; ++i) acc[a][b][i] = 0.f;
  u32x4 ra[PD][4], rp[PD][4], rb[PD][BN / 32]; f32x4 rm[PD][2];
  const int nk = K >> 6;
#pragma unroll
  for (int u = 0; u < PD; ++u) if (u < nk) gemm_gload<MIX, BN>(A, lda, B, ldb, m0, n0, u * 64, tid, ra[u], rp[u], rm[u], rb[u], mu);
  for (int kt0 = 0; kt0 < nk; kt0 += PD) {
#pragma unroll
    for (int u = 0; u < PD; ++u) {
      const int kt = kt0 + u;
      if (kt < nk) {
        LBAR();
        gemm_lstore<MIX, BN>(sA, sB, tid, ra[u], rp[u], rm[u], rb[u]);
        LBAR();
        if (kt + PD < nk) gemm_gload<MIX, BN>(A, lda, B, ldb, m0, n0, (kt + PD) * 64, tid, ra[u], rp[u], rm[u], rb[u], mu);
#pragma unroll
        for (int s = 0; s < 4; ++s) {
          const bf16x8 a0 = *(const bf16x8*)(sA + (wr * 64 + r) * LDT + s * 32 + h * 16);
          const bf16x8 a1 = *(const bf16x8*)(sA + (wr * 64 + 32 + r) * LDT + s * 32 + h * 16);
#pragma unroll
          for (int ni = 0; ni < NI; ++ni) {
            const bf16x8 bq = *(const bf16x8*)(sB + (wc * (BN / 2) + ni * 32 + r) * LDT + s * 32 + h * 16);
            acc[0][ni] = MFMA32(a0, bq, acc[0][ni]);
            acc[1][ni] = MFMA32(a1, bq, acc[1][ni]);
          }
        }
      }
    }
  }
  __builtin_amdgcn_sched_barrier(0);
  LBAR();
  constexpr int NIP = NI >= 2 ? 2 : 1;
  constexpr int SW = 32 * NIP + 4;
  constexpr int LPR = 8 * NIP;
  constexpr int RPI = 64 / LPR;
  float* stg = (float*)smem + wid * (32 * 68);
#pragma unroll
  for (int mi = 0; mi < 2; ++mi)
#pragma unroll
    for (int np = 0; np < NI / NIP; ++np) {
#pragma unroll
      for (int nn = 0; nn < NIP; ++nn)
#pragma unroll
        for (int i = 0; i < 16; ++i) stg[crow(i, h) * SW + 32 * nn + r] = acc[mi][np * NIP + nn][i];
#pragma unroll
      for (int it0 = 0; it0 < 32 / RPI; it0 += 4) {
        PV pv[4];
#pragma unroll
        for (int q = 0; q < 4; ++q) {
          const int rr = (it0 + q) * RPI + lane / LPR, c4 = (lane % LPR) * 4;
          pv[q] = pre(m0 + wr * 64 + mi * 32 + rr, n0 + wc * (BN / 2) + np * NIP * 32 + c4);
        }
#pragma unroll
        for (int q = 0; q < 4; ++q) {
          const int rr = (it0 + q) * RPI + lane / LPR, c4 = (lane % LPR) * 4;
          const f32x4 v = *(const f32x4*)(stg + rr * SW + c4);
          epi(m0 + wr * 64 + mi * 32 + rr, n0 + wc * (BN / 2) + np * NIP * 32 + c4, v, pv[q]);
        }
      }
    }
}

DEV void transpose_tile(const float* src, int ld, int kv, int c0, int cv, int special, bf16_t* dst, int ldd, int tt, char* smem) {
  const int tid = otid();
  const int nkt = ldd >> 6;
  const int n0 = (tt / nkt) * 64, k0 = (tt % nkt) * 64;
  float* tile = (float*)smem;
  const int nn = tid & 63;
  int scol; bool cvld;
  { const int gi = n0 + nn;
    if (special) { cvld = gi < 12; scol = gi < 8 ? 2048 + gi : 3592 + (gi - 8); }
    else { cvld = gi < cv; scol = c0 + gi; } }
  const int scl = cvld ? scol : 0;
  float tv[16];
#pragma unroll
  for (int i = 0; i < 16; ++i) {
    const int k = k0 + (tid >> 6) + 4 * i;
    tv[i] = src[(size_t)(k < kv ? k : kv - 1) * ld + scl];
  }
#pragma unroll
  for (int i = 0; i < 16; ++i) {
    const int kk = (tid >> 6) + 4 * i, k = k0 + kk;
    tile[kk * 65 + nn] = (cvld && k < kv) ? tv[i] : 0.f;
  }
  __syncthreads();
  const int kk2 = (tid & 31) * 2;
#pragma unroll
  for (int i = 0; i < 8; ++i) {
    const int nn2 = (tid >> 5) + 8 * i;
    *(unsigned*)(dst + (size_t)(n0 + nn2) * ldd + k0 + kk2) = pk2(tile[kk2 * 65 + nn2], tile[(kk2 + 1) * 65 + nn2]);
  }
}
constexpr int ADA_TASKS = 384;

DEV void phase0(const P& p, char* smem) {
  const int tid = otid();
  if (blockIdx.x == 0 && tid < 32) ((unsigned*)(p.ws + O_CTR))[tid] = 0u;
  if (blockIdx.x == 0 && tid == 64) {
    float mq = 0.f, mk = 0.f;
    for (int i = 0; i < 128; ++i) { mq = fmaxf(mq, fabsf(p.in[20][i])); mk = fmaxf(mk, fabsf(p.in[21][i])); }
    ((float*)(p.ws + O_CTR))[40] = 106.f + 2.f * mq * mk * 11.313708499f;
  }
  constexpr int ttiles = (2048/64)*16 + (1536/64)*16 + 2*16 + 16*16 + 64*16 + 16*64 + 3*16*16 + 2*16 + 2*16 + 4*16 + 16 + 16 + 16*3 + 16*16 + 64*16 + 16*64;
  const int total = ADA_TASKS + ttiles;
  for (int task = blockIdx.x; task < total; task += gridDim.x) {
    __syncthreads();
    if (task < ADA_TASKS) {
      const int layer = task / 192, j0 = (task % 192) * 32;
      const float* aw = layer ? p.in[26] : p.in[11]; const float* ab = layer ? p.in[27] : p.in[12];
      float* sc = (float*)smem;
      float* red = sc + 9 * 1024;
      for (int e = tid; e < 9 * 1024; e += NTHREADS) {
        const int s_ = e >> 10, k = e & 1023;
        const float c = s_ == 0 ? p.in[2][k] : p.in[3][(s_ - 1) * 1024 + k];
        sc[e] = siluf_(c);
      }
      __syncthreads();
      const int kp = tid >> 5, jj = tid & 31;
      float part[9];
#pragma unroll
      for (int s_ = 0; s_ < 9; ++s_) part[s_] = 0.f;
      const float* wp = aw + (size_t)(kp * 128) * 6144 + j0 + jj;
      for (int k0 = 0; k0 < 128; k0 += 16) {
        float wv[16];
#pragma unroll
        for (int u = 0; u < 16; ++u) wv[u] = wp[(size_t)(k0 + u) * 6144];
#pragma unroll
        for (int u = 0; u < 16; ++u)
#pragma unroll
          for (int s_ = 0; s_ < 9; ++s_) part[s_] += sc[s_ * 1024 + kp * 128 + k0 + u] * wv[u];
      }
#pragma unroll
      for (int s_ = 0; s_ < 9; ++s_) red[(kp * 9 + s_) * 32 + jj] = part[s_];
      __syncthreads();
      float* mod = (float*)(p.ws + O_MOD) + (size_t)layer * 9 * 6144;
      for (int o = tid; o < 288; o += NTHREADS) {
        const int s_ = o >> 5, j = o & 31;
        float v = ab[j0 + j];
#pragma unroll
        for (int q = 0; q < 8; ++q) v += red[(q * 9 + s_) * 32 + j];
        mod[s_ * 6144 + j0 + j] = v;
      }
    } else {
      int tt = task - ADA_TASKS;
      char* w = p.ws;
#define TRY_T(SRC, LD, KV, C0, CV, SP, DST, LDD, NROWS) { const int nt_ = ((NROWS) >> 6) * ((LDD) >> 6); if (tt >= 0 && tt < nt_) transpose_tile(SRC, LD, KV, C0, CV, SP, DST, LDD, tt, smem); tt -= nt_; }
      TRY_T(p.in[15], 3596, 1024, 0, 2048, 0, (bf16_t*)(w + O_WIN), 1024, 2048)
      TRY_T(p.in[15], 3596, 1024, 2056, 1536, 0, (bf16_t*)(w + O_WIN) + 2048 * 1024, 1024, 1536)
      TRY_T(p.in[15], 3596, 1024, 0, 12, 1, (bf16_t*)(w + O_WIN) + 3584 * 1024, 1024, 128)
      TRY_T(p.in[23], 1024, 1024, 0, 1024, 0, (bf16_t*)(w + O_WOUT), 1024, 1024)
      TRY_T(p.in[24], 4096, 1024, 0, 4096, 0, (bf16_t*)(w + O_FF1_0), 1024, 4096)
      TRY_T(p.in[25], 1024, 4096, 0, 1024, 0, (bf16_t*)(w + O_FF2_0), 4096, 1024)
      TRY_T(p.in[31], 1024, 1024, 0, 1024, 0, (bf16_t*)(w + O_RKV), 1024, 1024)
      TRY_T(p.in[32], 1024, 1024, 0, 1024, 0, (bf16_t*)(w + O_RKV) + 1024 * 1024, 1024, 1024)
      TRY_T(p.in[33], 1024, 1024, 0, 1024, 0, (bf16_t*)(w + O_RKV) + 2048 * 1024, 1024, 1024)
      TRY_T(p.in[35], 64, 1024, 0, 64, 0, (bf16_t*)(w + O_LORA1), 1024, 128)
      TRY_T(p.in[38], 64, 1024, 0, 64, 0, (bf16_t*)(w + O_LORA1) + 128 * 1024, 1024, 128)
      TRY_T(p.in[40], 160, 1024, 0, 160, 0, (bf16_t*)(w + O_LORA1) + 256 * 1024, 1024, 256)
      TRY_T(p.in[36], 1024, 64, 0, 1024, 0, (bf16_t*)(w + O_W2), 64, 1024)
      TRY_T(p.in[39], 1024, 64, 0, 1024, 0, (bf16_t*)(w + O_A2), 64, 1024)
      TRY_T(p.in[41], 1024, 160, 0, 1024, 0, (bf16_t*)(w + O_G2), 192, 1024)
      TRY_T(p.in[47], 1024, 1024, 0, 1024, 0, (bf16_t*)(w + O_WO), 1024, 1024)
      TRY_T(p.in[48], 4096, 1024, 0, 4096, 0, (bf16_t*)(w + O_FF1_1), 1024, 4096)
      TRY_T(p.in[49], 1024, 4096, 0, 1024, 0, (bf16_t*)(w + O_FF2_1), 4096, 1024)
    }
  }
}

DEV void rownorm_phase(const P& p, const float* src_or_null, const float* gain, int layer, int shidx, int scidx, bf16_t* dst, int mode) {
  const int tid_ = otid(); const int lane = tid_ & 63, wid = tid_ >> 6;
  const float* mod = (const float*)(p.ws + O_MOD) + (size_t)layer * 9 * 6144;
  const int nrows = mode == 1 ? T + 9 : T;
  for (int row = blockIdx.x * 4 + wid; row < nrows; row += gridDim.x * 4) {
    if (row >= T) {
      const int s = row - T;
      const int pr = s == 0 ? 0 : TP + 1 + 17 * (s - 1);
#pragma unroll
      for (int j = 0; j < 4; ++j) {
        const int c = lane * 4 + 256 * j;
        f32x4 v = {0.f, 0.f, 0.f, 0.f};
        if (s > 0) v = *(const f32x4*)(p.in[9] + (size_t)(s - 1) * D + c);
        u32x2 o; o[0] = pk2(v[0], v[1]); o[1] = pk2(v[2], v[3]);
        *(u32x2*)(dst + (size_t)pr * D + c) = o;
      }
      continue;
    }
    const float* src = src_or_null ? src_or_null + (size_t)row * D : xin_row(p, row);
    f32x4 v[4]; float ss = 0.f;
#pragma unroll
    for (int j = 0; j < 4; ++j) { v[j] = *(const f32x4*)(src + lane * 4 + 256 * j); ss += v[j][0] * v[j][0] + v[j][1] * v[j][1] + v[j][2] * v[j][2] + v[j][3] * v[j][3]; }
    ss = wave_sum(ss);
    const float rstd = rsqrtf(ss * (1.f / 1024.f) + 1e-6f);
    const int st = stream_of(row);
    const float* sh = mod + st * 6144 + shidx * 1024; const float* sc = mod + st * 6144 + scidx * 1024;
    size_t drow = row;
    if (mode == 1) drow = row < TP ? row + 1 : row + 2 + ((row - TP) >> 4);
    const bool last = mode == 1 && (row == TP - 1 || (row >= TP && ((row - TP) & 15) == 15));
    f32x4 gq[4], aq[4], bq_[4];
#pragma unroll
    for (int j = 0; j < 4; ++j) { const int c = lane * 4 + 256 * j; gq[j] = *(const f32x4*)(gain + c); aq[j] = *(const f32x4*)(sh + c); bq_[j] = *(const f32x4*)(sc + c); }
#pragma unroll
    for (int j = 0; j < 4; ++j) {
      const int c = lane * 4 + 256 * j;
      const f32x4 g = gq[j], a = aq[j], b = bq_[j];
      f32x4 o;
#pragma unroll
      for (int e = 0; e < 4; ++e) o[e] = v[j][e] * rstd * g[e] * (1.f + b[e]) + a[e];
      u32x2 ob; ob[0] = pk2(o[0], o[1]); ob[1] = pk2(o[2], o[3]);
      *(u32x2*)(dst + drow * D + c) = ob;
      if (last) *(f32x4*)(p.out + OUT_SHIFT + (size_t)st * D + c) = o;
    }
  }
}

DEV void fox_prep_tile(const P& p, int tile, char* smem) {
  const int tid = otid(), lane = tid & 63, wid = tid >> 6;
  float* lf = (float*)smem;
  bf16_t* proj = (bf16_t*)(p.ws + O_PROJ);
  const float* pab = (const float*)(p.ws + O_PAB);
  const float* qn = p.in[20]; const float* kn = p.in[21]; const float* fb = p.in[22];
  __syncthreads();
  for (int rr = wid * 32; rr < wid * 32 + 32; ++rr) {
    const int row = tile * 128 + rr;
    bf16_t* pr = proj + (size_t)row * NPROJ;
    unsigned uq[4], uk[4], uv[4];
#pragma unroll
    for (int hd = 0; hd < 4; ++hd) {
      const int c = hd * 128 + lane * 2;
      uq[hd] = *(const unsigned*)(pr + 2048 + c); uk[hd] = *(const unsigned*)(pr + 2560 + c); uv[hd] = *(const unsigned*)(pr + 3072 + c);
    }
    const float qn0 = qn[lane * 2], qn1 = qn[lane * 2 + 1], kn0 = kn[lane * 2], kn1 = kn[lane * 2 + 1];
#pragma unroll
    for (int hd = 0; hd < 4; ++hd) {
      const int c = hd * 128 + lane * 2;
      { const float a = bflo(uq[hd]), b = bfhi(uq[hd]);
        const float ss = wave_sum(a * a + b * b); const float rs = rsqrtf(ss * (1.f / 128.f) + 1e-6f) * 0.08838834764831845f * LOG2E;
        *(unsigned*)(pr + 2048 + c) = pk2(a * rs * qn0, b * rs * qn1); }
      { const float a = bflo(uk[hd]), b = bfhi(uk[hd]);
        const float ss = wave_sum(a * a + b * b); const float rs = rsqrtf(ss * (1.f / 128.f) + 1e-6f);
        f32x2 o = {a * rs * kn0, b * rs * kn1};
        *(f32x2*)(p.out + OUT_FK + (size_t)row * 512 + c) = o; }
      { f32x2 o = {bflo(uv[hd]), bfhi(uv[hd])};
        *(f32x2*)(p.out + OUT_FV + (size_t)row * 512 + c) = o; }
    }
    if (lane < 4) {
      const float f = logsigmoidf_(pab[(size_t)row * 16 + 8 + lane] + fb[lane]);
      p.out[OUT_LOGF + (size_t)row * 4 + lane] = f;
      lf[rr * 4 + lane] = f;
    }
  }
  __syncthreads();
  if (tid < 4) {
    float* cl = (float*)(p.ws + O_CL); float run = 0.f;
    for (int rr = 0; rr < 128; ++rr) { run += lf[rr * 4 + tid]; cl[(size_t)(tile * 128 + rr) * 4 + tid] = run; }
    ((float*)(p.ws + O_TOT))[tile * 4 + tid] = run;
  }
}

DEV int img_off128(int l, int k) {
  const int p = perm16(k & 15); const int cidx = (k >> 4) * 2 + (p >> 3);
  return l * 256 + ((cidx ^ (l & 15)) << 4) + (p & 7) * 2;
}
DEV int img_off64(int rowi, int j) {
  const int p = perm16(j & 15); const int cidx = (j >> 4) * 2 + (p >> 3);
  return rowi * 128 + ((cidx ^ ((rowi >> 1) & 7)) << 4) + (p & 7) * 2;
}

struct ConvCtx { const bf16_t* proj; const float* cache; const float* cw; int row0, L, first, stream; };
DEV float conv_raw(const ConvCtx& c, int rr, int ch) {
  if (rr >= 0) return bf2f(c.proj[(size_t)(c.row0 + rr) * NPROJ + ch]);
  if (!c.first) return bf2f(c.proj[(size_t)(c.row0 + rr) * NPROJ + ch]);
  if (c.stream == 0) return 0.f;
  return c.cache[((size_t)(c.stream - 1) * 3 + (3 + rr)) * 1536 + ch];
}

DEV void gdn_prep_item(const P& p, int item, char* smem) {
  const int tid = otid(), lane = tid & 63, wid = tid >> 6;
  const int ci = item >> 2, hd = item & 3;
  ConvCtx cc; cc.proj = (const bf16_t*)(p.ws + O_PROJ); cc.cache = p.in[4]; cc.cw = p.in[16];
  if (ci < 256) { cc.row0 = ci * 64; cc.L = 64; cc.stream = 0; cc.first = ci == 0; }
  else { cc.row0 = TP + (ci - 256) * 16; cc.L = 16; cc.stream = 1 + (ci - 256); cc.first = 1; }
  const int L = cc.L;
  float* ks = (float*)smem;
  float* As = ks + 64 * 132;
  float* sbeta = As + 64 * 68;
  float* sg = sbeta + 64, *sgc = sg + 64, *seg = sgc + 64;
  const float* pab = (const float*)(p.ws + O_PAB);
  char* img = p.ws + O_GIMG + (size_t)item * GIMG_BYTES;
  __syncthreads();
  {
    const int c = tid & 127, half = tid >> 7, ch = 512 + hd * 128 + c;
    const float w0 = cc.cw[ch], w1 = cc.cw[1536 + ch], w2 = cc.cw[2 * 1536 + ch], w3 = cc.cw[3 * 1536 + ch];
    const int rbeg = half * 32;
    float xr[35];
#pragma unroll
    for (int i = 0; i < 3; ++i) { const int rr = rbeg - 3 + i; xr[i] = (rr < L) ? conv_raw(cc, rr, ch) : 0.f; }
#pragma unroll
    for (int i = 3; i < 35; ++i) { const int rr = rbeg - 3 + i; const float t_ = bf2f(cc.proj[(size_t)(cc.row0 + (rr < L ? rr : L - 1)) * NPROJ + ch]); xr[i] = (rr < L) ? t_ : 0.f; }
#pragma unroll
    for (int i = 0; i < 32; ++i) {
      const int rr = rbeg + i; float o = 0.f;
      if (rr < L) o = siluf_(xr[i] * w0 + xr[i + 1] * w1 + xr[i + 2] * w2 + xr[i + 3] * w3);
      ks[rr * 132 + c] = o;
    }
  }
  if (tid < 64) {
    const int rr = tid; float be = 0.f, g = 0.f;
    if (rr < L) {
      const float braw = pab[(size_t)(cc.row0 + rr) * 16 + hd], araw = pab[(size_t)(cc.row0 + rr) * 16 + 4 + hd];
      be = sigmoidf_(braw); g = -__expf(p.in[17][hd]) * softplusf_(araw + p.in[18][hd]);
    }
    sbeta[rr] = be; sg[rr] = g;
  }
  __syncthreads();
  for (int rr = wid * 16; rr < wid * 16 + 16; ++rr) {
    const float a = ks[rr * 132 + lane], b = ks[rr * 132 + lane + 64];
    const float ss = wave_sum(a * a + b * b); const float rs = rsqrtf(ss + 1e-6f);
    ks[rr * 132 + lane] = a * rs; ks[rr * 132 + lane + 64] = b * rs;
  }
  if (tid == 0) {
    float run = 0.f;
    for (int rr = 0; rr < 64; ++rr) { run += sg[rr]; sgc[rr] = run; seg[rr] = __expf(run); }
    ((float*)(p.ws + O_GL))[item] = run;
  }
  __syncthreads();
  {
    const int ti = tid >> 4, tj = tid & 15;
    float acc[4][4];
#pragma unroll
    for (int a = 0; a < 4; ++a)
#pragma unroll
      for (int b = 0; b < 4; ++b) acc[a][b] = 0.f;
    for (int d = 0; d < 128; d += 4) {
      f32x4 ka[4], kb[4];
#pragma unroll
      for (int a = 0; a < 4; ++a) { ka[a] = *(const f32x4*)(ks + (ti + 16 * a) * 132 + d); kb[a] = *(const f32x4*)(ks + (tj + 16 * a) * 132 + d); }
#pragma unroll
      for (int a = 0; a < 4; ++a)
#pragma unroll
        for (int b = 0; b < 4; ++b) acc[a][b] += ka[a][0] * kb[b][0] + ka[a][1] * kb[b][1] + ka[a][2] * kb[b][2] + ka[a][3] * kb[b][3];
    }
#pragma unroll
    for (int a = 0; a < 4; ++a)
#pragma unroll
      for (int b = 0; b < 4; ++b) {
        const int i = ti + 16 * a, j = tj + 16 * b;
        As[i * 68 + j] = (j < i) ? sbeta[i] * acc[a][b] * __expf(sgc[i] - sgc[j]) : 0.f;
      }
  }
  __syncthreads();
  {
    float x[64];
    if (tid < 128) {
      const int c = tid, ch = 1024 + hd * 128 + c;
      const float w0 = cc.cw[ch], w1 = cc.cw[1536 + ch], w2 = cc.cw[2 * 1536 + ch], w3 = cc.cw[3 * 1536 + ch];
      float x0 = conv_raw(cc, -3, ch), x1 = conv_raw(cc, -2, ch), x2 = conv_raw(cc, -1, ch);
#pragma unroll
      for (int rr = 0; rr < 64; ++rr) x[rr] = bf2f(cc.proj[(size_t)(cc.row0 + (rr < L ? rr : L - 1)) * NPROJ + ch]);
#pragma unroll
      for (int rr = 0; rr < 64; ++rr) {
        const float x3 = x[rr];
        x[rr] = (rr < L) ? siluf_(x0 * w0 + x1 * w1 + x2 * w2 + x3 * w3) * sbeta[rr] : 0.f;
        x0 = x1; x1 = x2; x2 = x3;
      }
    } else {
      const int c = tid - 128;
#pragma unroll
      for (int rr = 0; rr < 64; ++rr) x[rr] = ks[rr * 132 + c] * sbeta[rr] * seg[rr];
    }
#pragma unroll
    for (int i = 1; i < 64; ++i) {
      float a = x[i];
#pragma unroll
      for (int j4 = 0; j4 < (i + 3) / 4; ++j4) {
        const f32x4 av = *(const f32x4*)(As + i * 68 + j4 * 4);
        a -= av[0] * x[4 * j4 + 0];
        if (4 * j4 + 1 < i) a -= av[1] * x[4 * j4 + 1];
        if (4 * j4 + 2 < i) a -= av[2] * x[4 * j4 + 2];
        if (4 * j4 + 3 < i) a -= av[3] * x[4 * j4 + 3];
      }
      x[i] = a;
      __builtin_amdgcn_sched_barrier(0);
    }
    if (tid < 128) {
      const int c = tid, w = c >> 5, ll = c & 31;
      bf16_t* uvb = (bf16_t*)(img + 57344) + (w * 128 + ll) * 16;
#pragma unroll
      for (int rr = 0; rr < 64; ++rr) {
        const int mt = rr >> 5, r5 = rr & 31, hh = (r5 >> 2) & 1, ii = (r5 & 3) + 4 * (r5 >> 3);
        uvb[(mt * 64 + 32 * hh) * 16 + ii] = f2bf(x[rr]);
        if ((rr & 7) == 7) __builtin_amdgcn_sched_barrier(0);
      }
    } else {
      const int c = tid - 128;
      const int pp = perm16(c & 15), cidx = (c >> 4) * 2 + (pp >> 3);
#pragma unroll
      for (int q = 0; q < 16; ++q) {
        char* bq = img + q * 256 + ((cidx ^ q) << 4) + (pp & 7) * 2;
#pragma unroll
        for (int g = 0; g < 4; ++g) *(bf16_t*)(bq + g * 4096) = f2bf(-x[16 * g + q]);
        __builtin_amdgcn_sched_barrier(0);
      }
    }
  }
  __syncthreads();
  float* qs = As;
  for (int hq = 0; hq < 2; ++hq) {
    {
      const int c = tid & 127, sub = tid >> 7, ch = hd * 128 + c;
      const float w0 = cc.cw[ch], w1 = cc.cw[1536 + ch], w2 = cc.cw[2 * 1536 + ch], w3 = cc.cw[3 * 1536 + ch];
      const int rbeg = hq * 32 + sub * 16;
      float xr[19];
#pragma unroll
      for (int i = 0; i < 3; ++i) { const int rr = rbeg - 3 + i; xr[i] = (rr < L) ? conv_raw(cc, rr, ch) : 0.f; }
#pragma unroll
      for (int i = 3; i < 19; ++i) { const int rr = rbeg - 3 + i; const float t_ = bf2f(cc.proj[(size_t)(cc.row0 + (rr < L ? rr : L - 1)) * NPROJ + ch]); xr[i] = (rr < L) ? t_ : 0.f; }
#pragma unroll
      for (int i = 0; i < 16; ++i) {
        const int rr = rbeg + i; float o = 0.f;
        if (rr < L) o = siluf_(xr[i] * w0 + xr[i + 1] * w1 + xr[i + 2] * w2 + xr[i + 3] * w3);
        qs[(rr - hq * 32) * 132 + c] = o;
      }
    }
    __syncthreads();
    for (int lr = wid * 8; lr < wid * 8 + 8; ++lr) {
      const float a = qs[lr * 132 + lane], b = qs[lr * 132 + lane + 64];
      const float ss = wave_sum(a * a + b * b); const float rs = rsqrtf(ss + 1e-6f) * 0.08838834764831845f;
      qs[lr * 132 + lane] = a * rs; qs[lr * 132 + lane + 64] = b * rs;
    }
    __syncthreads();
    {
      const int c = tid & 127, sub = tid >> 7;
      for (int i = 0; i < 16; ++i) {
        const int lr = sub * 16 + i, rr = hq * 32 + lr;
        *(bf16_t*)(img + 16384 + img_off128(rr, c)) = f2bf(qs[lr * 132 + c] * seg[rr]);
      }
      const int ti = tid >> 4, tj = tid & 15;
      float acc[2][4];
#pragma unroll
      for (int a = 0; a < 2; ++a)
#pragma unroll
        for (int b = 0; b < 4; ++b) acc[a][b] = 0.f;
      for (int d = 0; d < 128; d += 4) {
        f32x4 qa[2], kb[4];
#pragma unroll
        for (int a = 0; a < 2; ++a) qa[a] = *(const f32x4*)(qs + (ti + 16 * a) * 132 + d);
#pragma unroll
        for (int b = 0; b < 4; ++b) kb[b] = *(const f32x4*)(ks + (tj + 16 * b) * 132 + d);
#pragma unroll
        for (int a = 0; a < 2; ++a)
#pragma unroll
          for (int b = 0; b < 4; ++b) acc[a][b] += qa[a][0] * kb[b][0] + qa[a][1] * kb[b][1] + qa[a][2] * kb[b][2] + qa[a][3] * kb[b][3];
      }
#pragma unroll
      for (int a = 0; a < 2; ++a)
#pragma unroll
        for (int b = 0; b < 4; ++b) {
          const int i = hq * 32 + ti + 16 * a, j = tj + 16 * b;
          const float v = (j <= i) ? acc[a][b] * __expf(sgc[i] - sgc[j]) : 0.f;
          *(bf16_t*)(img + 32768 + img_off64(i, j)) = f2bf(v);
        }
    }
    __syncthreads();
  }
  {
    const int c = tid & 127, lb = (tid >> 7) * 32;
    const float glast = sgc[63];
    for (int i = 0; i < 32; ++i) {
      const int l = lb + i;
      *(bf16_t*)(img + 40960 + img_off64(c, l)) = f2bf(ks[l * 132 + c] * __expf(glast - sgc[l]));
    }
  }
}

DEV void gdn_scan_item(const P& p, int sitem, char* smem) {
  const int tid = otid(), lane = tid & 63, w = tid >> 6, r = lane & 31, h = lane >> 5;
  int stream, hd, half, nchunks, item0, row0, L;
  if (sitem < 8) { stream = 0; hd = sitem >> 1; half = sitem & 1; nchunks = 256; item0 = hd; row0 = 0; L = 64; }
  else { const int n = sitem - 8; const int b = n >> 3; hd = (n >> 1) & 3; half = n & 1; stream = 1 + b; nchunks = 1; item0 = (256 + b) * 4 + hd; row0 = TP + 16 * b; L = 16; }
  __syncthreads();
  if (w >= 2) {
    const unsigned lo = (unsigned)(tid - 128) * 16u;
    u32x4 ra[28];
#define GS_LOAD(REG, C) { const char* img_ = p.ws + O_GIMG + (size_t)(item0 + (C) * 4) * GIMG_BYTES; _Pragma("unroll") for (int i = 0; i < 28; ++i) REG[i] = *(const u32x4*)((img_ + 2048 * i) + lo); }
#define GS_STORE(REG) { _Pragma("unroll") for (int i = 0; i < 28; ++i) *(u32x4*)(smem + 2048 * i + lo) = REG[i]; }
    float* orawl = (float*)(p.ws + O_ORAW);
#define GS_OCOPY(CC) { _Pragma("unroll") for (int i = 0; i < 8; ++i) { const unsigned B_ = 2048u * i + lo; const f32x4 ov_ = *(const f32x4*)(smem + B_); \
        const int w_ = B_ >> 13, row_ = (B_ & 8191u) >> 7, c4_ = ((B_ & 127u) >> 4) * 4; \
        if (row_ < L) *(f32x4*)(orawl + (size_t)(row0 + (CC) * 64 + row_) * 512 + hd * 128 + 32 * (2 * half + w_) + c4_) = ov_; __builtin_amdgcn_sched_barrier(0); } }
    GS_LOAD(ra, 0)
    for (int c = 0; c < nchunks; ++c) {
      LBAR();
      if (c > 0) GS_OCOPY(c - 1)
#pragma unroll
      for (int i = 0; i < 16; ++i) *(u32x4*)(smem + 2048 * i + lo) = ra[i];
      LBAR();
#pragma unroll
      for (int i = 16; i < 28; ++i) *(u32x4*)(smem + 2048 * i + lo) = ra[i];
      if (c + 1 < nchunks) GS_LOAD(ra, c + 1)
      LBAR();
    }
    LBAR();
    GS_OCOPY(nchunks - 1)
  } else {
    const int vs = 2 * half + w;
    f32x16 S[4];
#pragma unroll
    for (int kt = 0; kt < 4; ++kt)
#pragma unroll
      for (int i = 0; i < 16; ++i) {
        float v = 0.f;
        if (stream > 0) v = p.in[5][(((size_t)(stream - 1) * 4 + hd) * 128 + 32 * kt + crow(i, h)) * 128 + 32 * vs + r];
        S[kt][i] = v;
      }
    const float* gl = (const float*)(p.ws + O_GL);
    float* oraw = (float*)(p.ws + O_ORAW);
    const unsigned uoff = (unsigned)(vs * 128 + lane) * 32u;
    u32x4 pu[4]; float gln;
    int a1[8], a2[4];
#pragma unroll
    for (int q = 0; q < 8; ++q) a1[q] = r * 256 + (((2 * q + h) ^ (r & 15)) << 4);
#pragma unroll
    for (int q = 0; q < 4; ++q) a2[q] = 32768 + r * 128 + (((2 * q + h) ^ ((r >> 1) & 7)) << 4);
    {
      const char* img = p.ws + O_GIMG + (size_t)item0 * GIMG_BYTES;
      gln = gl[item0];
#pragma unroll
      for (int mt = 0; mt < 2; ++mt) { pu[2 * mt] = *(const u32x4*)((img + 57344 + mt * 2048) + uoff); pu[2 * mt + 1] = *(const u32x4*)((img + 57344 + mt * 2048 + 16) + uoff); }
    }
    for (int c = 0; c < nchunks; ++c) {
      const int item = item0 + c * 4;
      LBAR();
      f32x16 U[2], O[2];
#pragma unroll
      for (int mt = 0; mt < 2; ++mt) {
#pragma unroll
        for (int e = 0; e < 4; ++e) { U[mt][2 * e] = bflo(pu[2 * mt][e]); U[mt][2 * e + 1] = bfhi(pu[2 * mt][e]); U[mt][8 + 2 * e] = bflo(pu[2 * mt + 1][e]); U[mt][8 + 2 * e + 1] = bfhi(pu[2 * mt + 1][e]); }
#pragma unroll
        for (int i = 0; i < 16; ++i) O[mt][i] = 0.f;
      }
      const float gamma = __expf(gln);
      if (c + 1 < nchunks) {
        const char* img = p.ws + O_GIMG + (size_t)(item + 4) * GIMG_BYTES;
        gln = gl[item + 4];
#pragma unroll
        for (int mt = 0; mt < 2; ++mt) { pu[2 * mt] = *(const u32x4*)((img + 57344 + mt * 2048) + uoff); pu[2 * mt + 1] = *(const u32x4*)((img + 57344 + mt * 2048 + 16) + uoff); }
      }
      LBAR();
      bf16x8 FA[8], FB[8];
#define LD1(F, KT) { _Pragma("unroll") for (int s_ = 0; s_ < 2; ++s_) { const char* b_ = smem + a1[2 * (KT) + s_]; \
        F[4 * s_ + 0] = *(const bf16x8*)(b_); F[4 * s_ + 1] = *(const bf16x8*)(b_ + 16384); F[4 * s_ + 2] = *(const bf16x8*)(b_ + 8192); F[4 * s_ + 3] = *(const bf16x8*)(b_ + 8192 + 16384); } }
#define MM1(F, KT) { _Pragma("unroll") for (int s_ = 0; s_ < 2; ++s_) { const bf16x8 sf_ = pack8(S[KT], s_); \
        U[0] = MFMA32(F[4 * s_ + 0], sf_, U[0]); O[0] = MFMA32(F[4 * s_ + 1], sf_, O[0]); U[1] = MFMA32(F[4 * s_ + 2], sf_, U[1]); O[1] = MFMA32(F[4 * s_ + 3], sf_, O[1]); } }
#define LD2(F) { _Pragma("unroll") for (int q_ = 0; q_ < 4; ++q_) { const char* b_ = smem + a2[q_]; F[2 * q_] = *(const bf16x8*)(b_); F[2 * q_ + 1] = *(const bf16x8*)(b_ + 4096); } }
#define LD3(F, M2) { _Pragma("unroll") for (int s_ = 0; s_ < 2; ++s_) { const char* b_ = smem + 8192 + a2[2 * (M2) + s_]; _Pragma("unroll") for (int kt_ = 0; kt_ < 4; ++kt_) F[4 * s_ + kt_] = *(const bf16x8*)(b_ + 4096 * kt_); } }
#define MM3(F, M2) { _Pragma("unroll") for (int s_ = 0; s_ < 2; ++s_) { _Pragma("unroll") for (int kt_ = 0; kt_ < 4; ++kt_) S[kt_] = MFMA32(F[4 * s_ + kt_], uf[M2][s_], S[kt_]); } }
#define SB __builtin_amdgcn_sched_barrier(0);
      LD1(FA, 0) SB
      LD1(FB, 1) SB MM1(FA, 0) SB
      LD1(FA, 2) SB MM1(FB, 1) SB
      LD1(FB, 3) SB MM1(FA, 2) SB
      MM1(FB, 3) SB
      LBAR();
      LD2(FA) SB
      bf16x8 uf[2][2];
#pragma unroll
      for (int mt = 0; mt < 2; ++mt)
#pragma unroll
        for (int s = 0; s < 2; ++s) uf[mt][s] = pack8(U[mt], s);
      LD3(FB, 0) SB
#pragma unroll
      for (int q = 0; q < 4; ++q) { O[0] = MFMA32(FA[2 * q], uf[q >> 1][q & 1], O[0]); O[1] = MFMA32(FA[2 * q + 1], uf[q >> 1][q & 1], O[1]); }
      {
        float* os_ = (float*)smem + w * 2048 + 4 * h * 32 + r;
#pragma unroll
        for (int mt = 0; mt < 2; ++mt)
#pragma unroll
          for (int i = 0; i < 16; ++i) os_[(32 * mt + (i & 3) + 8 * (i >> 2)) * 32] = O[mt][i];
      }
#pragma unroll
      for (int kt = 0; kt < 4; ++kt)
#pragma unroll
        for (int i = 0; i < 16; ++i) S[kt][i] *= gamma;
      SB
      LD3(FA, 1) SB MM3(FB, 0) SB
      MM3(FA, 1) SB
    }
    LBAR();
    float* dout = p.out + OUT_DELTA + ((size_t)stream * 4 + hd) * 128 * 128;
#pragma unroll
    for (int kt = 0; kt < 4; ++kt)
#pragma unroll
      for (int i = 0; i < 16; ++i) dout[(size_t)(32 * kt + crow(i, h)) * 128 + 32 * vs + r] = S[kt][i];
  }
}

DEV void fox_attn_item(const P& p, int aitem, char* smem) {
  const int tid = otid(), lane = tid & 63, w = tid >> 6, r = lane & 31, h = lane >> 5;
  int hd, b = 0, qrow0, nq, nkeys, qpos0, ntiles; bool dec;
  if (aitem < 32) { dec = true; b = aitem >> 2; hd = aitem & 3; qrow0 = TP + 16 * b; nq = 16; nkeys = 4112; qpos0 = 4096; ntiles = 129; }
  else { const int n = aitem - 32; dec = false; hd = n & 3; const int qb = 127 - (n >> 2); qrow0 = 128 * qb; nq = 128; nkeys = TP; qpos0 = qrow0; ntiles = ((qrow0 + 127) >> 5) + 1; }
  char* sK = smem; char* sV = smem + 8192;
  float* sck = (float*)(smem + 16384);
  float* sbase = (float*)(smem + 16640);
  float* sred = (float*)(smem + 16640 + 4352 * 4);
  const float* fk = p.out + OUT_FK; const float* fv = p.out + OUT_FV;
  const float* cl = (const float*)(p.ws + O_CL);
  __syncthreads();
  if (!dec) {
    if (tid == 0) { const float* tot = (const float*)(p.ws + O_TOT); float run = 0.f; for (int t = 0; t < 128; ++t) { sbase[t] = run; run += tot[t * 4 + hd]; } sbase[128] = run; }
  } else {
    float run = 0.f;
#pragma unroll 1
    for (int e = 0; e < 17; ++e) {
      const int j = tid * 17 + e; float v = 0.f;
      if (j < 4096) v = p.in[8][((size_t)b * 4096 + j) * 4 + hd];
      else if (j < 4112) v = p.out[OUT_LOGF + (size_t)(TP + 16 * b + (j - 4096)) * 4 + hd];
      run += v; sbase[j] = run;
    }
    sred[tid] = run;
    __syncthreads();
    if (tid == 0) { float a = 0.f; for (int t = 0; t < 256; ++t) { const float x = sred[t]; sred[t] = a; a += x; } }
    __syncthreads();
    const float basev = sred[tid];
#pragma unroll 1
    for (int e = 0; e < 17; ++e) sbase[tid * 17 + e] += basev;
  }
  __syncthreads();
  int kt_lo = 0;
  {
    const float thr = ((const float*)(p.ws + O_CTR))[40];
    if (!dec) {
      const float ci0 = sbase[qrow0 >> 7] + cl[(size_t)qrow0 * 4 + hd];
      int tb = 0;
      while (tb < (qrow0 >> 7) && ci0 - sbase[tb + 1] < -thr) ++tb;
      kt_lo = 4 * tb;
    } else {
      const float ci0 = sbase[4096];
      while (kt_lo < 128 && ci0 - sbase[32 * kt_lo + 31] < -thr) ++kt_lo;
    }
  }
  const bool active = 32 * w < nq;
  const int qi = 32 * w + r;
  const bool qvalid = qi < nq;
  const int qrow = qrow0 + (qvalid ? qi : 0);
  const int qpos = qpos0 + qi;
  float cq;
  if (!dec) cq = sbase[qpos >> 7] + cl[(size_t)qpos * 4 + hd]; else cq = sbase[qvalid ? qpos : 4096];
  cq *= LOG2E;
  bf16x8 qf[8];
  {
    const bf16_t* qp = (const bf16_t*)(p.ws + O_PROJ) + (size_t)qrow * NPROJ + 2048 + hd * 128 + 8 * h;
#pragma unroll
    for (int ks = 0; ks < 8; ++ks) qf[ks] = *(const bf16x8*)(qp + 16 * ks);
  }
  f32x16 O[4];
#pragma unroll
  for (int dt = 0; dt < 4; ++dt)
#pragma unroll
    for (int i = 0; i < 16; ++i) O[dt][i] = 0.f;
  float m = -1e30f, lsum = 0.f;
  const int kkl = tid >> 3, ksub = tid & 7;
  const int vkl = tid & 31, vdg = tid >> 5;
  f32x4 kreg[4], vreg[4]; float ckreg = 0.f;
  auto krow_ptr = [&](const float* base_out, const float* cache, int j) -> const float* {
    j = j < nkeys ? j : nkeys - 1;
    const float* p_new = base_out + ((size_t)(dec ? TP + 16 * b + (j - 4096) : j) * 4 + hd) * 128;
    const float* p_old = cache + (((size_t)b * 4096 + (j < 4096 ? j : 0)) * 4 + hd) * 128;
    return (dec && j < 4096) ? p_old : p_new;
  };
  auto gload = [&](int kt) {
    const float* kp = krow_ptr(fk, p.in[6], kt * 32 + kkl);
    const float* vp = krow_ptr(fv, p.in[7], kt * 32 + vkl);
#pragma unroll
    for (int e = 0; e < 4; ++e) {
      kreg[e] = *(const f32x4*)(kp + 16 * ksub + 4 * e);
      vreg[e] = *(const f32x4*)(vp + 16 * vdg + 4 * e);
    }
    if (tid < 32) {
      const int j = kt * 32 + tid;
      float c = 0.f;
      if (j < nkeys) c = dec ? sbase[j] : sbase[j >> 7] + cl[(size_t)j * 4 + hd];
      ckreg = c * LOG2E;
    }
  };
  gload(kt_lo);
  for (int kt = kt_lo; kt < ntiles; ++kt) {
    __syncthreads();
#pragma unroll
    for (int e = 0; e < 2; ++e) {
      const int cidx = ksub * 2 + e;
      u32x4 o; o[0] = pk2(kreg[2 * e][0], kreg[2 * e][1]); o[1] = pk2(kreg[2 * e][2], kreg[2 * e][3]);
      o[2] = pk2(kreg[2 * e + 1][0], kreg[2 * e + 1][1]); o[3] = pk2(kreg[2 * e + 1][2], kreg[2 * e + 1][3]);
      *(u32x4*)(sK + kkl * 256 + ((cidx ^ (kkl & 15)) << 4)) = o;
    }
    {
      const int pos = (vkl & ~15) + perm16(vkl & 15);
#pragma unroll
      for (int e = 0; e < 4; ++e)
#pragma unroll
        for (int f = 0; f < 4; ++f) {
          const int d = 16 * vdg + 4 * e + f;
          *(bf16_t*)(sV + d * 64 + (((pos >> 3) ^ ((d >> 2) & 3)) << 4) + (pos & 7) * 2) = f2bf(vreg[e][f]);
        }
    }
    if (tid < 32) sck[tid] = ckreg;
    __syncthreads();
    if (kt + 1 < ntiles) gload(kt + 1);
    if (active && (kt * 32 <= qpos0 + 32 * w + 31)) {
      f32x16 S;
#pragma unroll
      for (int i = 0; i < 16; ++i) S[i] = 0.f;
#pragma unroll
      for (int ks = 0; ks < 8; ++ks) {
        const bf16x8 a = *(const bf16x8*)(sK + r * 256 + (((2 * ks + h) ^ (r & 15)) << 4));
        S = MFMA32(a, qf[ks], S);
      }
      __builtin_amdgcn_sched_barrier(0);
      float mx = -INFINITY;
#pragma unroll
      for (int g = 0; g < 4; ++g) {
        const f32x4 ck4 = *(const f32x4*)(sck + 8 * g + 4 * h);
#pragma unroll
        for (int e = 0; e < 4; ++e) {
          const int i = 4 * g + e;
          const int kabs = kt * 32 + 8 * g + 4 * h + e;
          float sv = S[i] + (cq - ck4[e]);
          sv = (kabs <= qpos) ? sv : -INFINITY;
          S[i] = sv; mx = fmaxf(mx, sv);
        }
      }
      mx = fmaxf(mx, __shfl_xor(mx, 32));
      const float mn = fmaxf(m, mx);
      const float alpha = __builtin_amdgcn_exp2f(m - mn);
      m = mn;
      float ps = 0.f;
#pragma unroll
      for (int i = 0; i < 16; ++i) { const float pv = __builtin_amdgcn_exp2f(S[i] - mn); S[i] = pv; ps += pv; }
      lsum = lsum * alpha + ps;
#pragma unroll
      for (int dt = 0; dt < 4; ++dt)
#pragma unroll
        for (int i = 0; i < 16; ++i) O[dt][i] *= alpha;
      bf16x8 pf[2];
#pragma unroll
      for (int s = 0; s < 2; ++s) pf[s] = pack8(S, s);
      __builtin_amdgcn_sched_barrier(0);
#pragma unroll
      for (int dt = 0; dt < 4; ++dt)
#pragma unroll
        for (int s = 0; s < 2; ++s) {
          const int d = 32 * dt + r;
          const bf16x8 a = *(const bf16x8*)(sV + d * 64 + (((2 * s + h) ^ ((d >> 2) & 3)) << 4));
          O[dt] = MFMA32(a, pf[s], O[dt]);
        }
    }
  }
  if (active) {
    const float lt = lsum + __shfl_xor(lsum, 32);
    const float inv = 1.f / lt;
    if (qvalid) {
      bf16_t* op = (bf16_t*)(p.ws + O_R1) + (size_t)qrow * D + 512 + hd * 128;
#pragma unroll
      for (int dt = 0; dt < 4; ++dt)
#pragma unroll
        for (int g = 0; g < 4; ++g) {
          u32x2 o; o[0] = pk2(O[dt][4 * g] * inv, O[dt][4 * g + 1] * inv); o[1] = pk2(O[dt][4 * g + 2] * inv, O[dt][4 * g + 3] * inv);
          *(u32x2*)(op + 32 * dt + 8 * g + 4 * h) = o;
        }
    }
  }
}

DEV void wkv_scan_item(const P& p, int item, char* smem) {
  const int tid = otid(), lane = tid & 63, w = tid >> 6;
  int stream, hd, rg, row0, nsteps;
  if (item < 256) { stream = 0; hd = item >> 4; rg = item & 15; row0 = 0; nsteps = TP; }
  else { const int n = item - 256; const int b = n >> 8; stream = 1 + b; hd = (n >> 4) & 15; rg = n & 15; row0 = TP + 16 * b; nsteps = 16; }
  constexpr int BUF = 6 * 1024 + 16 * 8;
  float* bufs = (float*)smem;
  const bf16_t* rkv = (const bf16_t*)(p.ws + O_RKVB);
  const float* dec = (const float*)(p.ws + O_DEC);
  const bf16_t* ab = (const bf16_t*)(p.ws + O_AB);
  bf16_t* yraw = (bf16_t*)(p.ws + O_R1);
  const int nch = nsteps >> 4;
  __syncthreads();
  if (w > 0) {
    const int slot0 = tid - 64;
    const bool two = slot0 < 64;
    u32x2 rr_[4][2], kr_[4][2], vr_[4][2], ar_[4][2], kn_[4][2]; f32x4 dr_[4][2];
#define WKV_GLOAD(SET, C) { if ((C) < nch) { _Pragma("unroll") for (int q = 0; q < 2; ++q) { if (q == 1 && !two) break; \
        const int slot = slot0 + 192 * q; const int ltok = slot >> 4, ch = hd * 64 + (slot & 15) * 4; const size_t row = row0 + (C) * 16 + ltok; \
        rr_[SET][q] = *(const u32x2*)(rkv + row * 3072 + ch); kr_[SET][q] = *(const u32x2*)(rkv + row * 3072 + 1024 + ch); vr_[SET][q] = *(const u32x2*)(rkv + row * 3072 + 2048 + ch); \
        kn_[SET][q] = *(const u32x2*)(rkv + (row + 1) * 3072 + 1024 + ch); \
        ar_[SET][q] = *(const u32x2*)(ab + row * 1024 + ch); dr_[SET][q] = *(const f32x4*)(dec + row * 1024 + ch); } } }
#define WKV_PREP(SET, BI) { float* bp = bufs + (BI) * BUF; _Pragma("unroll") for (int q = 0; q < 2; ++q) { if (q == 1 && !two) break; \
        const int slot = slot0 + 192 * q; const int ltok = slot >> 4, lc4 = (slot & 15) * 4, ch = hd * 64 + lc4; \
        const f32x4 kkw = *(const f32x4*)(p.in[42] + ch), kaw = *(const f32x4*)(p.in[43] + ch); \
        const f32x4 r4 = {bflo(rr_[SET][q][0]), bfhi(rr_[SET][q][0]), bflo(rr_[SET][q][1]), bfhi(rr_[SET][q][1])}; \
        const f32x4 k4 = {bflo(kr_[SET][q][0]), bfhi(kr_[SET][q][0]), bflo(kr_[SET][q][1]), bfhi(kr_[SET][q][1])}; \
        const f32x4 v4 = {bflo(vr_[SET][q][0]), bfhi(vr_[SET][q][0]), bflo(vr_[SET][q][1]), bfhi(vr_[SET][q][1])}; \
        const f32x4 a4 = {bflo(ar_[SET][q][0]), bfhi(ar_[SET][q][0]), bflo(ar_[SET][q][1]), bfhi(ar_[SET][q][1])}; \
        const f32x4 n4 = {bflo(kn_[SET][q][0]), bfhi(kn_[SET][q][0]), bflo(kn_[SET][q][1]), bfhi(kn_[SET][q][1])}; \
        f32x4 kk4 = k4 * kkw; float ss = kk4[0] * kk4[0] + kk4[1] * kk4[1] + kk4[2] * kk4[2] + kk4[3] * kk4[3]; ss = row16_sum(ss); \
        const float rs = rsqrtf(ss + 1e-6f); kk4 = kk4 * rs; \
        f32x4 kn4 = n4 * kkw; float sn = kn4[0] * kn4[0] + kn4[1] * kn4[1] + kn4[2] * kn4[2] + kn4[3] * kn4[3]; sn = row16_sum(sn); \
        const float rn = rsqrtf(sn + 1e-6f); kn4 = kn4 * rn; \
        f32x4 kp4, b4, z4; float be = 0.f, ka_ = 0.f; \
        _Pragma("unroll") for (int e = 0; e < 4; ++e) { kp4[e] = k4[e] * (1.f + (a4[e] - 1.f) * kaw[e]); b4[e] = -kk4[e] * a4[e]; z4[e] = dr_[SET][q][e] * kn4[e]; be += b4[e] * kn4[e]; ka_ += kp4[e] * kn4[e]; } \
        be = row16_sum(be); ka_ = row16_sum(ka_); \
        *(f32x4*)(bp + 0 * 1024 + ltok * 64 + lc4) = r4; *(f32x4*)(bp + 1 * 1024 + ltok * 64 + lc4) = dr_[SET][q]; \
        *(f32x4*)(bp + 2 * 1024 + ltok * 64 + lc4) = kp4; *(f32x4*)(bp + 3 * 1024 + ltok * 64 + lc4) = kk4; *(f32x4*)(bp + 4 * 1024 + ltok * 64 + lc4) = b4; \
        *(f32x4*)(bp + 5 * 1024 + ltok * 64 + lc4) = z4; \
        if ((slot & 15) == rg) *(f32x4*)(bp + 6 * 1024 + ltok * 8) = v4; \
        if ((slot & 15) == 0) { f32x2 bk_ = {be, ka_}; *(f32x2*)(bp + 6 * 1024 + ltok * 8 + 4) = bk_; } } }
    WKV_GLOAD(0, 0) WKV_GLOAD(1, 1) WKV_GLOAD(2, 2) WKV_GLOAD(3, 3)
    WKV_PREP(0, 0)
    WKV_GLOAD(0, 4)
    LBAR();
    for (int c0 = 0; c0 < nch; c0 += 4) {
      { const int c = c0 + 0; if (c < nch) { if (c + 1 < nch) { WKV_PREP(1, 1) WKV_GLOAD(1, c + 5) } LBAR(); } }
      { const int c = c0 + 1; if (c < nch) { if (c + 1 < nch) { WKV_PREP(2, 0) WKV_GLOAD(2, c + 5) } LBAR(); } }
      { const int c = c0 + 2; if (c < nch) { if (c + 1 < nch) { WKV_PREP(3, 1) WKV_GLOAD(3, c + 5) } LBAR(); } }
      { const int c = c0 + 3; if (c < nch) { if (c + 1 < nch) { WKV_PREP(0, 0) WKV_GLOAD(0, c + 5) } LBAR(); } }
    }
  } else {
    const int rowl = lane >> 4, myrow = 4 * rg + rowl, c4 = (lane & 15) * 4;
    f32x4 st = {0.f, 0.f, 0.f, 0.f};
    if (stream > 0) st = *(const f32x4*)(p.in[10] + (((size_t)(stream - 1) * 16 + hd) * 64 + myrow) * 64 + c4);
    f32x2 slo = {st[0], st[1]}, shi = {st[2], st[3]};
    LBAR();
    float sa;
    { const f32x4 kk0 = *(const f32x4*)(bufs + 3 * 1024 + c4); sa = row16_sum(st[0] * kk0[0] + st[1] * kk0[1] + st[2] * kk0[2] + st[3] * kk0[3]); }
    for (int c = 0; c < nch; ++c) {
      const float* bp = bufs + (c & 1) * BUF;
      const float* bq = bp + c4;
      const float* bv = bp + 6 * 1024 + rowl;
      const float* bk = bp + 6 * 1024 + 4;
      float ykeep = 0.f, yprev = 0.f;
      f32x4 Z[16], W[16], NB[16], K[16], R[16]; float V[16]; f32x2 BK[16];
#define WLD(T) { Z[T] = *(const f32x4*)(bq + 5 * 1024 + (T) * 64); W[T] = *(const f32x4*)(bq + 1 * 1024 + (T) * 64); NB[T] = *(const f32x4*)(bq + 4 * 1024 + (T) * 64); \
        K[T] = *(const f32x4*)(bq + 2 * 1024 + (T) * 64); R[T] = *(const f32x4*)(bq + 0 * 1024 + (T) * 64); V[T] = bv[(T) * 8]; BK[T] = *(const f32x2*)(bk + (T) * 8); }
      WLD(0) WLD(1) WLD(2)
#pragma unroll
      for (int t = 0; t < 16; ++t) {
        if (t + 3 < 16) WLD(t + 3)
        __builtin_amdgcn_sched_barrier(0);
        const f32x4 z4 = Z[t], w4 = W[t], nb4 = NB[t], k4 = K[t], r4 = R[t]; const float vv = V[t]; const f32x2 bk2 = BK[t];
        const f32x2 zlo = {z4[0], z4[1]}, zhi = {z4[2], z4[3]}, wlo = {w4[0], w4[1]}, whi = {w4[2], w4[3]};
        const f32x2 nblo = {nb4[0], nb4[1]}, nbhi = {nb4[2], nb4[3]}, klo = {k4[0], k4[1]}, khi = {k4[2], k4[3]}, rlo = {r4[0], r4[1]}, rhi = {r4[2], r4[3]};
        f32x2 pp = slo * zlo; pp = shi * zhi + pp;
        float pr = pp[0] + pp[1];
        const f32x2 vklo = klo * vv, vkhi = khi * vv;
        const f32x2 tlo = nblo * sa + vklo, thi = nbhi * sa + vkhi;
        slo = slo * wlo + tlo; shi = shi * whi + thi;
        const float cnext = sa * bk2[0] + vv * bk2[1];
        pr = row16_sum(pr);
        if (t > 0) { const float yr = row16_sum(yprev); ykeep = ((lane & 15) == t - 1) ? yr : ykeep; }
        f32x2 qq = slo * rlo; qq = shi * rhi + qq;
        yprev = qq[0] + qq[1];
        sa = pr + cnext;
      }
      { const float yr = row16_sum(yprev); ykeep = ((lane & 15) == 15) ? yr : ykeep; }
      yraw[(size_t)(row0 + c * 16 + (lane & 15)) * 1024 + hd * 64 + myrow] = f2bf(ykeep);
      LBAR();
    }
    st = (f32x4){slo[0], slo[1], shi[0], shi[1]};
    *(f32x4*)(p.out + OUT_WKV + (((size_t)stream * 16 + hd) * 64 + myrow) * 64 + c4) = st;
  }
}

#define XB_TMO      128
#define XB_XCNT(j)  (256  + 64 * (j))
#define XB_XSUB(j)  (1280 + 64 * (j))
#define XB_XGEN(j)  (2304 + 64 * (j))
#define XB_TOP      3328
#define XB_TOPGEN   3392
#define XCD_BAR_WORDS 3456
#define XB_SPIN_CAP (1u << 20)
#define LAS3 __attribute__((address_space(3)))
DEV unsigned xb_ld(unsigned* p) { return __hip_atomic_load(p, __ATOMIC_RELAXED, __HIP_MEMORY_SCOPE_AGENT); }
DEV unsigned xb_add(unsigned* p, unsigned v) { return __hip_atomic_fetch_add(p, v, __ATOMIC_RELAXED, __HIP_MEMORY_SCOPE_AGENT); }
DEV unsigned xb_xcc_id() { return (unsigned)__builtin_amdgcn_s_getreg((3 << 11) | 20) & 0xFu; }
#define XB_SPIN(cond, bar) do { unsigned _sp = 0; while (cond) { __builtin_amdgcn_s_sleep(1); \
    if ((++_sp & 255u) == 0u) { if (xb_ld(&(bar)[XB_TMO])) break; if (_sp > XB_SPIN_CAP) { atomicAdd(&(bar)[XB_TMO], 1u); break; } } } } while (0)
struct XcdBarrier { unsigned* bar; unsigned x; volatile LAS3 unsigned* st; };
DEV XcdBarrier xcd_barrier_post(unsigned* bar, volatile LAS3 unsigned* st) {
  XcdBarrier b; b.bar = bar; b.x = xb_xcc_id(); b.st = st;
  if (threadIdx.x == 0) (void)xb_add(&bar[XB_XCNT(b.x)], 1u);
  return b;
}
DEV void xcd_barrier_complete(unsigned* bar, unsigned x, unsigned& nloc, unsigned& nx) {
  const unsigned G = gridDim.x;
  unsigned sum, cnt, mine, sp = 0u;
  for (;;) {
    sum = 0u; cnt = 0u; mine = 0u;
#pragma unroll
    for (unsigned j = 0; j < 16; ++j) { const unsigned c = xb_ld(&bar[XB_XCNT(j)]); sum += c; cnt += (c > 0u) ? 1u : 0u; mine = (j == x) ? c : mine; }
    if (sum == G) break;
    __builtin_amdgcn_s_sleep(1);
    if ((++sp & 255u) == 0u) { if (xb_ld(&bar[XB_TMO])) break; if (sp > XB_SPIN_CAP) { atomicAdd(&bar[XB_TMO], 1u); break; } }
  }
  nloc = mine > 0u ? mine : 1u; nx = cnt > 0u ? cnt : 1u;
}
DEV void xcd_barrier(const XcdBarrier& b) {
  asm volatile("s_waitcnt vmcnt(0)" ::: "memory");
  __syncthreads();
  if (threadIdx.x == 0) {
    unsigned* bar = b.bar;
    __builtin_amdgcn_s_waitcnt(0);
    unsigned nloc = b.st[0], nx = b.st[1];
    if (nloc == 0u) { xcd_barrier_complete(bar, b.x, nloc, nx); b.st[0] = nloc; b.st[1] = nx; }
    const unsigned old = xb_add(&bar[XB_XSUB(b.x)], 1u);
    const unsigned gen = old / nloc;
    if (old + 1u == (gen + 1u) * nloc) {
      __builtin_amdgcn_fence(__ATOMIC_RELEASE, "agent");
      asm volatile("s_waitcnt vmcnt(0)" ::: "memory");
      const unsigned og = xb_add(&bar[XB_TOP], 1u);
      const unsigned tg = og / nx;
      if (og + 1u == (tg + 1u) * nx) xb_add(&bar[XB_TOPGEN], 1u);
      else XB_SPIN(xb_ld(&bar[XB_TOPGEN]) == tg, bar);
      __builtin_amdgcn_fence(__ATOMIC_ACQUIRE, "agent");
      xb_add(&bar[XB_XGEN(b.x)], 1u);
      asm volatile("s_waitcnt vmcnt(0)" ::: "memory");
    } else {
      XB_SPIN(xb_ld(&bar[XB_XGEN(b.x)]) == gen, bar);
      __builtin_amdgcn_fence(__ATOMIC_ACQUIRE, "agent");
      asm volatile("s_waitcnt vmcnt(0)" ::: "memory");
    }
  }
  __syncthreads();
}

__global__ void __launch_bounds__(NTHREADS, 2) mega(P p) {
  cg::grid_group grid = cg::this_grid();
  __shared__ __attribute__((aligned(16))) char smem[SMEM_BYTES];
  __shared__ int s_item;
  __shared__ __attribute__((aligned(16))) unsigned xb_st[4];
  const int tid = otid(), lane = tid & 63, wid = tid >> 6;
  const int G = gridDim.x, bid = blockIdx.x;
  char* ws = p.ws;
  const float* mod0 = (const float*)(ws + O_MOD);
  const float* mod1 = mod0 + 9 * 6144;
  float* xbuf = p.out + OUT_Y;
  bf16_t* R1 = (bf16_t*)(ws + O_R1);
  unsigned* bar = (unsigned*)(ws + O_BAR);
  if (threadIdx.x < 4) xb_st[threadIdx.x] = 0u;
  __syncthreads();
  const XcdBarrier xb = xcd_barrier_post(bar, (volatile LAS3 unsigned*)xb_st);

  phase0(p, smem);
  grid.sync();
  rownorm_phase(p, nullptr, p.in[13], 0, 0, 1, R1, 0);
  xcd_barrier(xb);
  {
    bf16_t* proj = (bf16_t*)(ws + O_PROJ); float* pab = (float*)(ws + O_PAB); float* conv = p.out + OUT_CONV;
    auto epi = [&](int row, int col, const f32x4& v, const PV& pv) {
      if (col < NPROJ) {
        st_bf4(proj + (size_t)row * NPROJ + col, v);
        if (col < 1536) {
          if (row >= TP - 3 && row < TP) *(f32x4*)(conv + (size_t)(row - (TP - 3)) * 1536 + col) = v;
          else if (row >= TP && ((row - TP) & 15) >= 13) *(f32x4*)(conv + ((size_t)(1 + ((row - TP) >> 4)) * 3 + (((row - TP) & 15) - 13)) * 1536 + col) = v;
        }
      } else if (col < NPROJ + 12) *(f32x4*)(pab + (size_t)row * 16 + (col - NPROJ)) = v;
    };
    for (int t = bid; t < 128 * 15 + 58; t += G) {
      if (t < 128 * 15) {
        const int mt = t / 15, j = t % 15;
        if (j < 14) gemm_tile<0, 256>(R1, D, (const bf16_t*)(ws + O_WIN), D, D, mt * 128, j * 256, smem, nullptr, epi);
        else gemm_tile<0, 128>(R1, D, (const bf16_t*)(ws + O_WIN), D, D, mt * 128, 3584, smem, nullptr, epi);
      } else gemm_tile<0, 64>(R1, D, (const bf16_t*)(ws + O_WIN), D, D, 128 * 128, (t - 128 * 15) * 64, smem, nullptr, epi);
    }
  }
  xcd_barrier(xb);
  for (int t = bid; t < 129 + GITEMS; t += G) {
#if PM & 4
    if (t < GITEMS) gdn_prep_item(p, t, smem); else fox_prep_tile(p, t - GITEMS, smem);
#endif
  }
  xcd_barrier(xb);
  {
  #if PM & 1
    if (bid < 72) gdn_scan_item(p, bid, smem);
#endif
    unsigned* ctr = (unsigned*)(ws + O_CTR);
    for (;;) {
      __syncthreads();
      if (tid == 0) s_item = (int)atomicAdd(ctr, 1u);
      __syncthreads();
      const int it = s_item;
      if (it >= 32 + 512) break;
#if PM & 2
      fox_attn_item(p, it, smem);
#endif
    }
  }
  xcd_barrier(xb);
  {
    const float* oraw = (const float*)(ws + O_ORAW); const bf16_t* proj = (const bf16_t*)(ws + O_PROJ); const float* on = p.in[19];
    for (int row = bid * 4 + wid; row < T; row += G * 4) {
#pragma unroll
      for (int hd = 0; hd < 4; ++hd) {
        const int c = hd * 128 + lane * 2;
        const f32x2 o = *(const f32x2*)(oraw + (size_t)row * 512 + c);
        const float ss = wave_sum(o[0] * o[0] + o[1] * o[1]); const float rs = rsqrtf(ss * (1.f / 128.f) + 1e-6f);
        const unsigned zu = *(const unsigned*)(proj + (size_t)row * NPROJ + 1536 + c);
        *(unsigned*)(R1 + (size_t)row * D + c) = pk2(o[0] * rs * on[lane * 2] * siluf_(bflo(zu)), o[1] * rs * on[lane * 2 + 1] * siluf_(bfhi(zu)));
      }
    }
  }
  xcd_barrier(xb);
  {
    auto pre = [&](int row, int col) { PV o; o.a = *(const f32x4*)(xin_row(p, row) + col); o.b = *(const f32x4*)(mod0 + stream_of(row) * 6144 + 2 * 1024 + col); return o; };
    auto epi = [&](int row, int col, const f32x4& v, const PV& pv) { *(f32x4*)(xbuf + (size_t)row * D + col) = pv.a + pv.b * v; };
    for (int t = bid; t < 512 + 16; t += G) {
      if (t < 512) gemm_tile<0, 256>(R1, D, (const bf16_t*)(ws + O_WOUT), D, D, (t >> 2) * 128, (t & 3) * 256, smem, nullptr, epi, pre);
      else gemm_tile<0, 64>(R1, D, (const bf16_t*)(ws + O_WOUT), D, D, 128 * 128, (t - 512) * 64, smem, nullptr, epi, pre);
    }
  }
  xcd_barrier(xb);
  rownorm_phase(p, xbuf, p.in[14], 0, 3, 4, R1, 0);
  xcd_barrier(xb);
  {
    bf16_t* hid = (bf16_t*)(ws + O_HID);
    auto epi = [&](int row, int col, const f32x4& v, const PV& pv) { f32x4 o; for (int e = 0; e < 4; ++e) { const float rl = fmaxf(v[e], 0.f); o[e] = rl * rl; } st_bf4(hid + (size_t)row * DFF + col, o); };
    for (int t = bid; t < 2048 + 64; t += G) {
      if (t < 2048) gemm_tile<0, 256>(R1, D, (const bf16_t*)(ws + O_FF1_0), D, D, (t >> 4) * 128, (t & 15) * 256, smem, nullptr, epi);
      else gemm_tile<0, 64>(R1, D, (const bf16_t*)(ws + O_FF1_0), D, D, 128 * 128, (t - 2048) * 64, smem, nullptr, epi);
    }
  }
  xcd_barrier(xb);
  {
    auto pre = [&](int row, int col) { PV o; o.a = *(const f32x4*)(xbuf + (size_t)row * D + col); o.b = *(const f32x4*)(mod0 + stream_of(row) * 6144 + 5 * 1024 + col); return o; };
    auto epi = [&](int row, int col, const f32x4& v, const PV& pv) { *(f32x4*)(xbuf + (size_t)row * D + col) = pv.a + pv.b * v; };
    for (int t = bid; t < 512 + 16; t += G) {
      if (t < 512) gemm_tile<0, 256>((const bf16_t*)(ws + O_HID), DFF, (const bf16_t*)(ws + O_FF2_0), DFF, DFF, (t >> 2) * 128, (t & 3) * 256, smem, nullptr, epi, pre);
      else gemm_tile<0, 64>((const bf16_t*)(ws + O_HID), DFF, (const bf16_t*)(ws + O_FF2_0), DFF, DFF, 128 * 128, (t - 512) * 64, smem, nullptr, epi, pre);
    }
  }
  xcd_barrier(xb);
  rownorm_phase(p, xbuf, p.in[28], 1, 0, 1, R1, 1);
  xcd_barrier(xb);
  {
    bf16_t* rkvb = (bf16_t*)(ws + O_RKVB); bf16_t* lw = (bf16_t*)(ws + O_LW); bf16_t* la = (bf16_t*)(ws + O_LA); bf16_t* lg = (bf16_t*)(ws + O_LG);
    auto epi_rkv = [&](int row, int col, const f32x4& v, const PV& pv) { st_bf4(rkvb + (size_t)row * 3072 + col, v); };
    for (int t = bid; t < 128 * 16 + 56; t += G) {
      int m0, n0, kind;
      if (t < 128 * 16) { const int j = t & 15; m0 = (t >> 4) * 128; if (j < 12) { n0 = j * 256; kind = 0; } else { n0 = 3072 + (j - 12) * 128; kind = 1; } }
      else { m0 = 128 * 128; n0 = (t - 128 * 16) * 64; kind = 2; }
      if (n0 < 3072) {
        const int g = n0 >> 10; const int mui = g == 0 ? 0 : (g == 1 ? 2 : 3);
        if (kind == 0) gemm_tile<1, 256>(R1, D, (const bf16_t*)(ws + O_RKV), D, D, m0, n0, smem, p.in[30] + mui * 1024, epi_rkv);
        else gemm_tile<1, 64>(R1, D, (const bf16_t*)(ws + O_RKV), D, D, m0, n0, smem, p.in[30] + mui * 1024, epi_rkv);
      } else {
        const int nt = 24 + ((n0 - 3072) >> 7);
        const int mui = nt == 24 ? 1 : (nt == 25 ? 4 : 5);
        auto epi = [&](int row, int col, const f32x4& v, const PV& pv) {
          if (nt == 24) { if (col < 64) { const f32x4 o = {tanhf(v[0]), tanhf(v[1]), tanhf(v[2]), tanhf(v[3])}; st_bf4(lw + (size_t)row * 64 + col, o); } }
          else if (nt == 25) { const int c = col - 128; if (c < 64) st_bf4(la + (size_t)row * 64 + c, v); }
          else { const int c = col - 256; if (c < 192) { f32x4 o = {0.f, 0.f, 0.f, 0.f}; if (c < 160) o = (f32x4){sigmoidf_(v[0]), sigmoidf_(v[1]), sigmoidf_(v[2]), sigmoidf_(v[3])}; st_bf4(lg + (size_t)row * 192 + c, o); } }
        };
        if (kind == 1) gemm_tile<1, 128>(R1, D, (const bf16_t*)(ws + O_LORA1), D, D, m0, n0 - 3072, smem, p.in[30] + mui * 1024, epi);
        else gemm_tile<1, 64>(R1, D, (const bf16_t*)(ws + O_LORA1), D, D, m0, n0 - 3072, smem, p.in[30] + mui * 1024, epi);
      }
    }
  }
  xcd_barrier(xb);
  {
    float* dec = (float*)(ws + O_DEC); bf16_t* abuf = (bf16_t*)(ws + O_AB); bf16_t* gate = (bf16_t*)(ws + O_GATE);
    const float* w0 = p.in[34]; const float* a0 = p.in[37];
    for (int t = bid; t < 129 * 24; t += G) {
      const int mt = t / 24, nt = t % 24, g = nt >> 3, n0 = (nt & 7) * 128;
      if (g == 0) {
        auto pre = [&](int row, int col) { PV o; o.a = *(const f32x4*)(w0 + col); o.b = o.a; return o; };
        auto epi = [&](int row, int col, const f32x4& v, const PV& pv) { f32x4 o; for (int e = 0; e < 4; ++e) { const float wl = -softplusf_(-(pv.a[e] + v[e])) - 0.5f; o[e] = __expf(-__expf(wl)); } *(f32x4*)(dec + (size_t)row * D + col) = o; };
        gemm_tile<0>((const bf16_t*)(ws + O_LW), 64, (const bf16_t*)(ws + O_W2), 64, 64, mt * 128, n0, smem, nullptr, epi, pre);
      } else if (g == 1) {
        auto pre = [&](int row, int col) { PV o; o.a = *(const f32x4*)(a0 + col); o.b = o.a; return o; };
        auto epi = [&](int row, int col, const f32x4& v, const PV& pv) { f32x4 o; for (int e = 0; e < 4; ++e) o[e] = sigmoidf_(pv.a[e] + v[e]); st_bf4(abuf + (size_t)row * D + col, o); };
        gemm_tile<0>((const bf16_t*)(ws + O_LA), 64, (const bf16_t*)(ws + O_A2), 64, 64, mt * 128, n0, smem, nullptr, epi, pre);
      } else {
        auto epi = [&](int row, int col, const f32x4& v, const PV& pv) { st_bf4(gate + (size_t)row * D + col, v); };
        gemm_tile<0>((const bf16_t*)(ws + O_LG), 192, (const bf16_t*)(ws + O_G2), 192, 192, mt * 128, n0, smem, nullptr, epi);
      }
    }
  }
  xcd_barrier(xb);
#if PM & 8
  if (G > 256) {
    if (bid < 256) wkv_scan_item(p, bid, smem);
    else for (int it = 256 + (bid - 256); it < 256 + 2048; it += G - 256) wkv_scan_item(p, it, smem);
  } else {
    for (int it = bid; it < 256 + 2048; it += G) wkv_scan_item(p, it, smem);
  }
#endif
  xcd_barrier(xb);
  {
    const bf16_t* yraw = R1; const bf16_t* rkvb = (const bf16_t*)(ws + O_RKVB); const bf16_t* abuf = (const bf16_t*)(ws + O_AB);
    const bf16_t* gate = (const bf16_t*)(ws + O_GATE); bf16_t* ybf = (bf16_t*)(ws + O_DEC);
    const float* ka = p.in[43]; const float* rk = p.in[44]; const float* lnw = p.in[45]; const float* lnb = p.in[46];
    for (int row = bid * 4 + wid; row < T; row += G * 4) {
      const int c0 = lane * 16;
      u32x4 yv[2], rv[2], kv[2], vv[2], av[2], gv[2];
#pragma unroll
      for (int q = 0; q < 2; ++q) {
        yv[q] = *(const u32x4*)(yraw + (size_t)row * D + c0 + 8 * q);
        rv[q] = *(const u32x4*)(rkvb + (size_t)row * 3072 + c0 + 8 * q);
        kv[q] = *(const u32x4*)(rkvb + (size_t)row * 3072 + 1024 + c0 + 8 * q);
        vv[q] = *(const u32x4*)(rkvb + (size_t)row * 3072 + 2048 + c0 + 8 * q);
        av[q] = *(const u32x4*)(abuf + (size_t)row * D + c0 + 8 * q);
        gv[q] = *(const u32x4*)(gate + (size_t)row * D + c0 + 8 * q);
      }
      float y[16]; float sum = 0.f, bs = 0.f;
#pragma unroll
      for (int e = 0; e < 16; ++e) {
        const unsigned yu = yv[e >> 3][(e >> 1) & 3], ru = rv[e >> 3][(e >> 1) & 3], ku = kv[e >> 3][(e >> 1) & 3], au = av[e >> 3][(e >> 1) & 3];
        const float yy = (e & 1) ? bfhi(yu) : bflo(yu), rr = (e & 1) ? bfhi(ru) : bflo(ru), kk = (e & 1) ? bfhi(ku) : bflo(ku), aa = (e & 1) ? bfhi(au) : bflo(au);
        y[e] = yy; sum += yy;
        const float kp = kk * (1.f + (aa - 1.f) * ka[c0 + e]);
        bs += rr * kp * rk[c0 + e];
      }
      sum = dpp_add(sum, 0); sum = dpp_add(sum, 1);
      bs = dpp_add(bs, 0); bs = dpp_add(bs, 1);
      const float mean = sum * (1.f / 64.f);
      float vs_ = 0.f;
#pragma unroll
      for (int e = 0; e < 16; ++e) { const float d = y[e] - mean; vs_ += d * d; }
      vs_ = dpp_add(vs_, 0); vs_ = dpp_add(vs_, 1);
      const float rstd = rsqrtf(vs_ * (1.f / 64.f) + 64e-5f);
      u32x4 ov[2];
#pragma unroll
      for (int e = 0; e < 16; e += 2) {
        float o2[2];
#pragma unroll
        for (int f = 0; f < 2; ++f) {
          const int ee = e + f;
          const unsigned vu = vv[ee >> 3][(ee >> 1) & 3], gu = gv[ee >> 3][(ee >> 1) & 3];
          const float vvv = (ee & 1) ? bfhi(vu) : bflo(vu), gg = (ee & 1) ? bfhi(gu) : bflo(gu);
          const float yn = (y[ee] - mean) * rstd * lnw[c0 + ee] + lnb[c0 + ee];
          o2[f] = (yn + bs * vvv) * gg;
        }
        ov[e >> 3][(e >> 1) & 3] = pk2(o2[0], o2[1]);
      }
      *(u32x4*)(ybf + (size_t)row * D + c0) = ov[0];
      *(u32x4*)(ybf + (size_t)row * D + c0 + 8) = ov[1];
    }
  }
  xcd_barrier(xb);
  {
    auto pre = [&](int row, int col) { PV o; o.a = *(const f32x4*)(xbuf + (size_t)row * D + col); o.b = *(const f32x4*)(mod1 + stream_of(row) * 6144 + 2 * 1024 + col); return o; };
    auto epi = [&](int row, int col, const f32x4& v, const PV& pv) { *(f32x4*)(xbuf + (size_t)row * D + col) = pv.a + pv.b * v; };
    for (int t = bid; t < 512 + 16; t += G) {
      if (t < 512) gemm_tile<0, 256>((const bf16_t*)(ws + O_DEC), D, (const bf16_t*)(ws + O_WO), D, D, (t >> 2) * 128, (t & 3) * 256, smem, nullptr, epi, pre);
      else gemm_tile<0, 64>((const bf16_t*)(ws + O_DEC), D, (const bf16_t*)(ws + O_WO), D, D, 128 * 128, (t - 512) * 64, smem, nullptr, epi, pre);
    }
  }
  xcd_barrier(xb);
  rownorm_phase(p, xbuf, p.in[29], 1, 3, 4, R1, 0);
  xcd_barrier(xb);
  {
    bf16_t* hid = (bf16_t*)(ws + O_HID);
    auto epi = [&](int row, int col, const f32x4& v, const PV& pv) { f32x4 o; for (int e = 0; e < 4; ++e) { const float rl = fmaxf(v[e], 0.f); o[e] = rl * rl; } st_bf4(hid + (size_t)row * DFF + col, o); };
    for (int t = bid; t < 2048 + 64; t += G) {
      if (t < 2048) gemm_tile<0, 256>(R1, D, (const bf16_t*)(ws + O_FF1_1), D, D, (t >> 4) * 128, (t & 15) * 256, smem, nullptr, epi);
      else gemm_tile<0, 64>(R1, D, (const bf16_t*)(ws + O_FF1_1), D, D, 128 * 128, (t - 2048) * 64, smem, nullptr, epi);
    }
  }
  xcd_barrier(xb);
  {
    auto pre = [&](int row, int col) { PV o; o.a = *(const f32x4*)(xbuf + (size_t)row * D + col); o.b = *(const f32x4*)(mod1 + stream_of(row) * 6144 + 5 * 1024 + col); return o; };
    auto epi = [&](int row, int col, const f32x4& v, const PV& pv) { *(f32x4*)(xbuf + (size_t)row * D + col) = pv.a + pv.b * v; };
    for (int t = bid; t < 512 + 16; t += G) {
      if (t < 512) gemm_tile<0, 256>((const bf16_t*)(ws + O_HID), DFF, (const bf16_t*)(ws + O_FF2_1), DFF, DFF, (t >> 2) * 128, (t & 3) * 256, smem, nullptr, epi, pre);
      else gemm_tile<0, 64>((const bf16_t*)(ws + O_HID), DFF, (const bf16_t*)(ws + O_FF2_1), DFF, DFF, 128 * 128, (t - 512) * 64, smem, nullptr, epi, pre);
    }
  }
}

extern "C" void kernel_launch(void* const* d_in, const int* in_sizes, int n_in, void* d_out, int out_size, void* d_ws, size_t ws_size,
                              hipStream_t stream) {
  static int grid_blocks = 0;
  if (!grid_blocks) {
    int dev = 0, cus = 0, per_cu = 0;
    hipGetDevice(&dev);
    hipDeviceGetAttribute(&cus, hipDeviceAttributeMultiprocessorCount, dev);
    hipOccupancyMaxActiveBlocksPerMultiprocessor(&per_cu, mega, NTHREADS, 0);
    if (per_cu > 2) per_cu = 2;
    grid_blocks = cus * per_cu;
    if (ws_size < WS_NEED) fprintf(stderr, "workspace too small: %zu < %zu\n", ws_size, (size_t)WS_NEED);
  }
  P p{};
  for (int i = 0; i < 50; ++i) p.in[i] = (const float*)d_in[i];
  p.out = (float*)d_out;
  p.ws = (char*)d_ws;
  (void)hipMemsetAsync((char*)d_ws + O_BAR, 0, 16384, stream);
  void* args[] = {&p};
  hipError_t e = hipLaunchCooperativeKernel((void*)mega, dim3(grid_blocks), dim3(NTHREADS), args, 0, stream);
  if (e != hipSuccess) fprintf(stderr, "cooperative launch failed: %s (grid %d)\n", hipGetErrorString(e), grid_blocks);
}
```

```cpp
#include <hip/hip_runtime.h>
#include <hip/hip_cooperative_groups.h>
#include <cstdio>
#include <cstdint>
namespace cg = cooperative_groups;
#ifndef PM
#define PM 255
#endif

#define DEV __device__ __forceinline__
typedef unsigned short bf16_t;
typedef short bf16x8 __attribute__((ext_vector_type(8)));
typedef float f32x2 __attribute__((ext_vector_type(2)));
typedef float f32x4 __attribute__((ext_vector_type(4)));
typedef float f32x16 __attribute__((ext_vector_type(16)));
typedef unsigned u32x2 __attribute__((ext_vector_type(2)));
typedef unsigned u32x4 __attribute__((ext_vector_type(4)));
typedef __bf16 bf2_t __attribute__((ext_vector_type(2)));

constexpr int D = 1024, TP = 16384, TS = 128, T = TP + TS, NS = 9, DFF = 4096;
constexpr int NWIN = 3712;
constexpr int NPROJ = 3584;
constexpr float LOG2E = 1.4426950408889634f;
constexpr int NTHREADS = 256;
constexpr int SMEM_BYTES = 57344 + 1024;

constexpr size_t OUT_Y = 0;
constexpr size_t OUT_CONV = OUT_Y + (size_t)T * D;
constexpr size_t OUT_DELTA = OUT_CONV + 9ull * 3 * 1536;
constexpr size_t OUT_FK = OUT_DELTA + 9ull * 4 * 128 * 128;
constexpr size_t OUT_FV = OUT_FK + (size_t)T * 512;
constexpr size_t OUT_LOGF = OUT_FV + (size_t)T * 512;
constexpr size_t OUT_SHIFT = OUT_LOGF + (size_t)T * 4;
constexpr size_t OUT_WKV = OUT_SHIFT + 9ull * 1024;
constexpr size_t OUT_TOTAL = OUT_WKV + 9ull * 16 * 64 * 64;

constexpr size_t al256(size_t x) { return (x + 255) & ~(size_t)255; }
constexpr size_t O_WIN = 0;
constexpr size_t O_WOUT = O_WIN + (size_t)NWIN * 1024 * 2;
constexpr size_t O_FF1_0 = O_WOUT + 1024ull * 1024 * 2;
constexpr size_t O_FF2_0 = O_FF1_0 + 4096ull * 1024 * 2;
constexpr size_t O_RKV = O_FF2_0 + 4096ull * 1024 * 2;
constexpr size_t O_LORA1 = O_RKV + 3072ull * 1024 * 2;
constexpr size_t O_W2 = O_LORA1 + 512ull * 1024 * 2;
constexpr size_t O_A2 = O_W2 + 1024ull * 64 * 2;
constexpr size_t O_G2 = O_A2 + 1024ull * 64 * 2;
constexpr size_t O_WO = O_G2 + 1024ull * 192 * 2;
constexpr size_t O_FF1_1 = O_WO + 1024ull * 1024 * 2;
constexpr size_t O_FF2_1 = O_FF1_1 + 4096ull * 1024 * 2;
constexpr size_t O_MOD = O_FF2_1 + 4096ull * 1024 * 2;
constexpr size_t O_CTR = O_MOD + 2ull * 9 * 6144 * 4;
constexpr size_t O_TOT = O_CTR + 256;
constexpr size_t O_CL = al256(O_TOT + 129 * 16);
constexpr size_t O_PAB = al256(O_CL + (size_t)T * 16);
constexpr size_t O_GL = al256(O_PAB + (size_t)T * 64);
constexpr size_t O_BAR = al256(O_GL + 8192);
constexpr size_t O_R1 = al256(O_BAR + 16384);
constexpr size_t R1_BYTES = 34ull << 20;
constexpr size_t O_R2 = O_R1 + R1_BYTES;
constexpr size_t O_PROJ = O_R2;
constexpr size_t O_GIMG = al256(O_PROJ + (size_t)T * NPROJ * 2);
constexpr int GITEMS = 264 * 4;
constexpr size_t GIMG_BYTES = 73728;
constexpr size_t O_ORAW = al256(O_GIMG + (size_t)GITEMS * GIMG_BYTES);
constexpr size_t L0_END = O_ORAW + (size_t)T * 512 * 4;
constexpr size_t O_HID = O_R2;
constexpr size_t O_RKVB = O_R2;
constexpr size_t O_LW = al256(O_RKVB + (size_t)T * 3072 * 2);
constexpr size_t O_LA = al256(O_LW + (size_t)T * 64 * 2);
constexpr size_t O_LG = al256(O_LA + (size_t)T * 64 * 2);
constexpr size_t O_DEC = al256(O_LG + (size_t)T * 192 * 2);
constexpr size_t O_AB = al256(O_DEC + (size_t)T * 1024 * 4);
constexpr size_t O_GATE = al256(O_AB + (size_t)T * 1024 * 2);
constexpr size_t L1_END = O_GATE + (size_t)T * 1024 * 2;
constexpr size_t HID_END = O_HID + (size_t)T * 4096 * 2;
constexpr size_t WS_NEED = (L0_END > L1_END ? (L0_END > HID_END ? L0_END : HID_END) : (L1_END > HID_END ? L1_END : HID_END));

struct P { const float* in[50]; float* out; char* ws; };

DEV unsigned pk2(float a, float b) { f32x2 v = {a, b}; bf2_t r = __builtin_convertvector(v, bf2_t); return __builtin_bit_cast(unsigned, r); }
DEV bf16_t f2bf(float a) { return (bf16_t)(pk2(a, 0.f) & 0xffffu); }
DEV void st_bf4(bf16_t* p, const f32x4& v) { u32x2 o; o[0] = pk2(v[0], v[1]); o[1] = pk2(v[2], v[3]); *(u32x2*)p = o; }
DEV float bf2f(bf16_t b) { return __uint_as_float(((unsigned)b) << 16); }
DEV float bflo(unsigned u) { return __uint_as_float(u << 16); }
DEV float bfhi(unsigned u) { return __uint_as_float(u & 0xffff0000u); }
DEV int otid() { int t = threadIdx.x; asm volatile("" : "+v"(t)); return t; }
DEV float dpp_add(float x, const int ctrl_sel) {
  int xi = __float_as_int(x), yi;
  if (ctrl_sel == 0) yi = __builtin_amdgcn_update_dpp(0, xi, 0xB1, 0xF, 0xF, true);
  else if (ctrl_sel == 1) yi = __builtin_amdgcn_update_dpp(0, xi, 0x4E, 0xF, 0xF, true);
  else if (ctrl_sel == 2) yi = __builtin_amdgcn_update_dpp(0, xi, 0x141, 0xF, 0xF, true);
  else yi = __builtin_amdgcn_update_dpp(0, xi, 0x140, 0xF, 0xF, true);
  return x + __int_as_float(yi);
}
DEV float row16_sum(float x) { x = dpp_add(x, 0); x = dpp_add(x, 1); x = dpp_add(x, 2); x = dpp_add(x, 3); return x; }
DEV float wave_sum(float v) {
  v = row16_sum(v);
  const int vi = __float_as_int(v);
  const float a = __int_as_float(__builtin_amdgcn_readlane(vi, 0)), b = __int_as_float(__builtin_amdgcn_readlane(vi, 16));
  const float c = __int_as_float(__builtin_amdgcn_readlane(vi, 32)), d = __int_as_float(__builtin_amdgcn_readlane(vi, 48));
  return (a + b) + (c + d);
}
DEV float sigmoidf_(float x) { return 1.f / (1.f + __expf(-x)); }
DEV float siluf_(float x) { return x / (1.f + __expf(-x)); }
DEV float softplusf_(float x) { return x > 20.f ? x : log1pf(__expf(x)); }
DEV float logsigmoidf_(float x) { return fminf(x, 0.f) - log1pf(__expf(-fabsf(x))); }
DEV int stream_of(int row) { return row < TP ? 0 : 1 + ((row - TP) >> 4); }
DEV int perm16(int o) { return 8 * ((o >> 2) & 1) + (o & 3) + 4 * (o >> 3); }
DEV int crow(int i, int h) { return (i & 3) + 8 * (i >> 2) + 4 * h; }
DEV bf16x8 pack8(const f32x16& x, const int s) {
  u32x4 p;
  p[0] = pk2(x[8 * s + 0], x[8 * s + 1]); p[1] = pk2(x[8 * s + 2], x[8 * s + 3]);
  p[2] = pk2(x[8 * s + 4], x[8 * s + 5]); p[3] = pk2(x[8 * s + 6], x[8 * s + 7]);
  return __builtin_bit_cast(bf16x8, p);
}
#define LBAR() asm volatile("s_waitcnt lgkmcnt(0)\n\ts_barrier" ::: "memory")
#define MFMA32(a, b, c) __builtin_amdgcn_mfma_f32_32x32x16_bf16((a), (b), (c), 0, 0, 0)
DEV const float* xin_row(const P& p, int row) { return row < TP ? p.in[0] + (size_t)row * D : p.in[1] + (size_t)(row - TP) * D; }

constexpr int LDT = 144;

template <int MIX, int BN>
DEV void gemm_gload(const bf16_t* A, int lda, const bf16_t* B, int ldb, int m0, int n0, int k0, int tid,
                    u32x4 (&ra)[4], u32x4 (&rp)[4], f32x4 (&rm)[2], u32x4 (&rb)[BN / 32], const float* mu) {
  const int kc = tid & 7, r0 = tid >> 3;
#pragma unroll
  for (int i = 0; i < 4; ++i) {
    const int row = r0 + 32 * i;
    if (!MIX) {
      ra[i] = *(const u32x4*)(A + (size_t)(m0 + row) * lda + k0 + kc * 8);
    } else {
      const int t = m0 + row;
      const int pr = t < TP ? t + 1 : t + 2 + ((t - TP) >> 4);
      ra[i] = *(const u32x4*)(A + (size_t)pr * D + k0 + kc * 8);
      rp[i] = *(const u32x4*)(A + (size_t)(pr - 1) * D + k0 + kc * 8);
    }
  }
#pragma unroll
  for (int i = 0; i < BN / 32; ++i) rb[i] = *(const u32x4*)(B + (size_t)(n0 + r0 + 32 * i) * ldb + k0 + kc * 8);
  if (MIX) { rm[0] = *(const f32x4*)(mu + k0 + kc * 8); rm[1] = *(const f32x4*)(mu + k0 + kc * 8 + 4); }
}
template <int MIX, int BN>
DEV void gemm_lstore(char* sA, char* sB, int tid, const u32x4 (&ra)[4], const u32x4 (&rp)[4], const f32x4 (&rm)[2], const u32x4 (&rb)[BN / 32]) {
  const int kc = tid & 7, r0 = tid >> 3;
#pragma unroll
  for (int i = 0; i < 4; ++i) {
    u32x4 o = ra[i];
    if (MIX) {
#pragma unroll
      for (int e = 0; e < 4; ++e) {
        const float h0 = bflo(ra[i][e]), h1 = bfhi(ra[i][e]), p0 = bflo(rp[i][e]), p1 = bfhi(rp[i][e]);
        const float ma = (e < 2) ? rm[0][2 * e] : rm[1][2 * e - 4], mb = (e < 2) ? rm[0][2 * e + 1] : rm[1][2 * e - 3];
        o[e] = pk2(h0 + (p0 - h0) * ma, h1 + (p1 - h1) * mb);
      }
    }
    *(u32x4*)(sA + (r0 + 32 * i) * LDT + kc * 16) = o;
  }
#pragma unroll
  for (int i = 0; i < BN / 32; ++i) *(u32x4*)(sB + (r0 + 32 * i) * LDT + kc * 16) = rb[i];
}

struct PV { f32x4 a, b; };
struct NoPre { DEV PV operator()(int, int) const { PV z; z.a = (f32x4){0.f, 0.f, 0.f, 0.f}; z.b = z.a; return z; } };
template <int MIX, int BN = 128, class Epi, class Pre = NoPre>
DEV void gemm_tile(const bf16_t* A, int lda, const bf16_t* B, int ldb, int K, int m0, int n0, char* smem, const float* mu, Epi epi, Pre pre = Pre()) {
  constexpr int PD = BN == 256 ? 1 : (MIX ? 2 : 3);
  constexpr int NI = BN / 64;
  char* sA = smem; char* sB = smem + 128 * LDT;
  const int tid = otid(), lane = tid & 63, wid = tid >> 6, wr = wid >> 1, wc = wid & 1, h = lane >> 5, r = lane & 31;
  f32x16 acc[2][NI];
#pragma unroll
  for (int a = 0; a < 2; ++a)
#pragma unroll
    for (int b = 0; b < NI; ++b)
#pragma unroll
      for (int i = 0; i < 16; ++i) acc[a][b][i] = 0.f;
  u32x4 ra[PD][4], rp[PD][4], rb[PD][BN / 32]; f32x4 rm[PD][2];
  const int nk = K >> 6;
#pragma unroll
  for (int u = 0; u < PD; ++u) if (u < nk) gemm_gload<MIX, BN>(A, lda, B, ldb, m0, n0, u * 64, tid, ra[u], rp[u], rm[u], rb[u], mu);
  for (int kt0 = 0; kt0 < nk; kt0 += PD) {
#pragma unroll
    for (int u = 0; u < PD; ++u) {
      const int kt = kt0 + u;
      if (kt < nk) {
        LBAR();
        gemm_lstore<MIX, BN>(sA, sB, tid, ra[u], rp[u], rm[u], rb[u]);
        LBAR();
        if (kt + PD < nk) gemm_gload<MIX, BN>(A, lda, B, ldb, m0, n0, (kt + PD) * 64, tid, ra[u], rp[u], rm[u], rb[u], mu);
#pragma unroll
        for (int s = 0; s < 4; ++s) {
          const bf16x8 a0 = *(const bf16x8*)(sA + (wr * 64 + r) * LDT + s * 32 + h * 16);
          const bf16x8 a1 = *(const bf16x8*)(sA + (wr * 64 + 32 + r) * LDT + s * 32 + h * 16);
#pragma unroll
          for (int ni = 0; ni < NI; ++ni) {
            const bf16x8 bq = *(const bf16x8*)(sB + (wc * (BN / 2) + ni * 32 + r) * LDT + s * 32 + h * 16);
            acc[0][ni] = MFMA32(a0, bq, acc[0][ni]);
            acc[1][ni] = MFMA32(a1, bq, acc[1][ni]);
          }
        }
      }
    }
  }
  __builtin_amdgcn_sched_barrier(0);
  LBAR();
  constexpr int NIP = NI >= 2 ? 2 : 1;
  constexpr int SW = 32 * NIP + 4;
  constexpr int LPR = 8 * NIP;
  constexpr int RPI = 64 / LPR;
  float* stg = (float*)smem + wid * (32 * 68);
#pragma unroll
  for (int mi = 0; mi < 2; ++mi)
#pragma unroll
    for (int np = 0; np < NI / NIP; ++np) {
#pragma unroll
      for (int nn = 0; nn < NIP; ++nn)
#pragma unroll
        for (int i = 0; i < 16; ++i) stg[crow(i, h) * SW + 32 * nn + r] = acc[mi][np * NIP + nn][i];
#pragma unroll
      for (int it0 = 0; it0 < 32 / RPI; it0 += 4) {
        PV pv[4];
#pragma unroll
        for (int q = 0; q < 4; ++q) {
          const int rr = (it0 + q) * RPI + lane / LPR, c4 = (lane % LPR) * 4;
          pv[q] = pre(m0 + wr * 64 + mi * 32 + rr, n0 + wc * (BN / 2) + np * NIP * 32 + c4);
        }
#pragma unroll
        for (int q = 0; q < 4; ++q) {
          const int rr = (it0 + q) * RPI + lane / LPR, c4 = (lane % LPR) * 4;
          const f32x4 v = *(const f32x4*)(stg + rr * SW + c4);
          epi(m0 + wr * 64 + mi * 32 + rr, n0 + wc * (BN / 2) + np * NIP * 32 + c4, v, pv[q]);
        }
      }
    }
}

DEV void transpose_tile(const float* src, int ld, int kv, int c0, int cv, int special, bf16_t* dst, int ldd, int tt, char* smem) {
  const int tid = otid();
  const int nkt = ldd >> 6;
  const int n0 = (tt / nkt) * 64, k0 = (tt % nkt) * 64;
  float* tile = (float*)smem;
  const int nn = tid & 63;
  int scol; bool cvld;
  { const int gi = n0 + nn;
    if (special) { cvld = gi < 12; scol = gi < 8 ? 2048 + gi : 3592 + (gi - 8); }
    else { cvld = gi < cv; scol = c0 + gi; } }
  const int scl = cvld ? scol : 0;
  float tv[16];
#pragma unroll
  for (int i = 0; i < 16; ++i) {
    const int k = k0 + (tid >> 6) + 4 * i;
    tv[i] = src[(size_t)(k < kv ? k : kv - 1) * ld + scl];
  }
#pragma unroll
  for (int i = 0; i < 16; ++i) {
    const int kk = (tid >> 6) + 4 * i, k = k0 + kk;
    tile[kk * 65 + nn] = (cvld && k < kv) ? tv[i] : 0.f;
  }
  __syncthreads();
  const int kk2 = (tid & 31) * 2;
#pragma unroll
  for (int i = 0; i < 8; ++i) {
    const int nn2 = (tid >> 5) + 8 * i;
    *(unsigned*)(dst + (size_t)(n0 + nn2) * ldd + k0 + kk2) = pk2(tile[kk2 * 65 + nn2], tile[(kk2 + 1) * 65 + nn2]);
  }
}
constexpr int ADA_TASKS = 384;

DEV void phase0(const P& p, char* smem) {
  const int tid = otid();
  if (blockIdx.x == 0 && tid < 32) ((unsigned*)(p.ws + O_CTR))[tid] = 0u;
  if (blockIdx.x == 0 && tid == 64) {
    float mq = 0.f, mk = 0.f;
    for (int i = 0; i < 128; ++i) { mq = fmaxf(mq, fabsf(p.in[20][i])); mk = fmaxf(mk, fabsf(p.in[21][i])); }
    ((float*)(p.ws + O_CTR))[40] = 106.f + 2.f * mq * mk * 11.313708499f;
  }
  constexpr int ttiles = (2048/64)*16 + (1536/64)*16 + 2*16 + 16*16 + 64*16 + 16*64 + 3*16*16 + 2*16 + 2*16 + 4*16 + 16 + 16 + 16*3 + 16*16 + 64*16 + 16*64;
  const int total = ADA_TASKS + ttiles;
  for (int task = blockIdx.x; task < total; task += gridDim.x) {
    __syncthreads();
    if (task < ADA_TASKS) {
      const int layer = task / 192, j0 = (task % 192) * 32;
      const float* aw = layer ? p.in[26] : p.in[11]; const float* ab = layer ? p.in[27] : p.in[12];
      float* sc = (float*)smem;
      float* red = sc + 9 * 1024;
      for (int e = tid; e < 9 * 1024; e += NTHREADS) {
        const int s_ = e >> 10, k = e & 1023;
        const float c = s_ == 0 ? p.in[2][k] : p.in[3][(s_ - 1) * 1024 + k];
        sc[e] = siluf_(c);
      }
      __syncthreads();
      const int kp = tid >> 5, jj = tid & 31;
      float part[9];
#pragma unroll
      for (int s_ = 0; s_ < 9; ++s_) part[s_] = 0.f;
      const float* wp = aw + (size_t)(kp * 128) * 6144 + j0 + jj;
      for (int k0 = 0; k0 < 128; k0 += 16) {
        float wv[16];
#pragma unroll
        for (int u = 0; u < 16; ++u) wv[u] = wp[(size_t)(k0 + u) * 6144];
#pragma unroll
        for (int u = 0; u < 16; ++u)
#pragma unroll
          for (int s_ = 0; s_ < 9; ++s_) part[s_] += sc[s_ * 1024 + kp * 128 + k0 + u] * wv[u];
      }
#pragma unroll
      for (int s_ = 0; s_ < 9; ++s_) red[(kp * 9 + s_) * 32 + jj] = part[s_];
      __syncthreads();
      float* mod = (float*)(p.ws + O_MOD) + (size_t)layer * 9 * 6144;
      for (int o = tid; o < 288; o += NTHREADS) {
        const int s_ = o >> 5, j = o & 31;
        float v = ab[j0 + j];
#pragma unroll
        for (int q = 0; q < 8; ++q) v += red[(q * 9 + s_) * 32 + j];
        mod[s_ * 6144 + j0 + j] = v;
      }
    } else {
      int tt = task - ADA_TASKS;
      char* w = p.ws;
#define TRY_T(SRC, LD, KV, C0, CV, SP, DST, LDD, NROWS) { const int nt_ = ((NROWS) >> 6) * ((LDD) >> 6); if (tt >= 0 && tt < nt_) transpose_tile(SRC, LD, KV, C0, CV, SP, DST, LDD, tt, smem); tt -= nt_; }
      TRY_T(p.in[15], 3596, 1024, 0, 2048, 0, (bf16_t*)(w + O_WIN), 1024, 2048)
      TRY_T(p.in[15], 3596, 1024, 2056, 1536, 0, (bf16_t*)(w + O_WIN) + 2048 * 1024, 1024, 1536)
      TRY_T(p.in[15], 3596, 1024, 0, 12, 1, (bf16_t*)(w + O_WIN) + 3584 * 1024, 1024, 128)
      TRY_T(p.in[23], 1024, 1024, 0, 1024, 0, (bf16_t*)(w + O_WOUT), 1024, 1024)
      TRY_T(p.in[24], 4096, 1024, 0, 4096, 0, (bf16_t*)(w + O_FF1_0), 1024, 4096)
      TRY_T(p.in[25], 1024, 4096, 0, 1024, 0, (bf16_t*)(w + O_FF2_0), 4096, 1024)
      TRY_T(p.in[31], 1024, 1024, 0, 1024, 0, (bf16_t*)(w + O_RKV), 1024, 1024)
      TRY_T(p.in[32], 1024, 1024, 0, 1024, 0, (bf16_t*)(w + O_RKV) + 1024 * 1024, 1024, 1024)
      TRY_T(p.in[33], 1024, 1024, 0, 1024, 0, (bf16_t*)(w + O_RKV) + 2048 * 1024, 1024, 1024)
      TRY_T(p.in[35], 64, 1024, 0, 64, 0, (bf16_t*)(w + O_LORA1), 1024, 128)
      TRY_T(p.in[38], 64, 1024, 0, 64, 0, (bf16_t*)(w + O_LORA1) + 128 * 1024, 1024, 128)
      TRY_T(p.in[40], 160, 1024, 0, 160, 0, (bf16_t*)(w + O_LORA1) + 256 * 1024, 1024, 256)
      TRY_T(p.in[36], 1024, 64, 0, 1024, 0, (bf16_t*)(w + O_W2), 64, 1024)
      TRY_T(p.in[39], 1024, 64, 0, 1024, 0, (bf16_t*)(w + O_A2), 64, 1024)
      TRY_T(p.in[41], 1024, 160, 0, 1024, 0, (bf16_t*)(w + O_G2), 192, 1024)
      TRY_T(p.in[47], 1024, 1024, 0, 1024, 0, (bf16_t*)(w + O_WO), 1024, 1024)
      TRY_T(p.in[48], 4096, 1024, 0, 4096, 0, (bf16_t*)(w + O_FF1_1), 1024, 4096)
      TRY_T(p.in[49], 1024, 4096, 0, 1024, 0, (bf16_t*)(w + O_FF2_1), 4096, 1024)
    }
  }
}

DEV void rownorm_phase(const P& p, const float* src_or_null, const float* gain, int layer, int shidx, int scidx, bf16_t* dst, int mode) {
  const int tid_ = otid(); const int lane = tid_ & 63, wid = tid_ >> 6;
  const float* mod = (const float*)(p.ws + O_MOD) + (size_t)layer * 9 * 6144;
  const int nrows = mode == 1 ? T + 9 : T;
  for (int row = blockIdx.x * 4 + wid; row < nrows; row += gridDim.x * 4) {
    if (row >= T) {
      const int s = row - T;
      const int pr = s == 0 ? 0 : TP + 1 + 17 * (s - 1);
#pragma unroll
      for (int j = 0; j < 4; ++j) {
        const int c = lane * 4 + 256 * j;
        f32x4 v = {0.f, 0.f, 0.f, 0.f};
        if (s > 0) v = *(const f32x4*)(p.in[9] + (size_t)(s - 1) * D + c);
        u32x2 o; o[0] = pk2(v[0], v[1]); o[1] = pk2(v[2], v[3]);
        *(u32x2*)(dst + (size_t)pr * D + c) = o;
      }
      continue;
    }
    const float* src = src_or_null ? src_or_null + (size_t)row * D : xin_row(p, row);
    const int st = stream_of(row);
    const float* sh = mod + st * 6144 + shidx * 1024; const float* sc = mod + st * 6144 + scidx * 1024;
    f32x4 v[4], gq[4], aq[4], bq_[4]; float ss = 0.f;
#pragma unroll
    for (int j = 0; j < 4; ++j) {
      const int c = lane * 4 + 256 * j;
      v[j] = *(const f32x4*)(src + c); gq[j] = *(const f32x4*)(gain + c); aq[j] = *(const f32x4*)(sh + c); bq_[j] = *(const f32x4*)(sc + c);
    }
#pragma unroll
    for (int j = 0; j < 4; ++j) ss += v[j][0] * v[j][0] + v[j][1] * v[j][1] + v[j][2] * v[j][2] + v[j][3] * v[j][3];
    ss = wave_sum(ss);
    const float rstd = rsqrtf(ss * (1.f / 1024.f) + 1e-6f);
    size_t drow = row;
    if (mode == 1) drow = row < TP ? row + 1 : row + 2 + ((row - TP) >> 4);
    const bool last = mode == 1 && (row == TP - 1 || (row >= TP && ((row - TP) & 15) == 15));
#pragma unroll
    for (int j = 0; j < 4; ++j) {
      const int c = lane * 4 + 256 * j;
      const f32x4 g = gq[j], a = aq[j], b = bq_[j];
      f32x4 o;
#pragma unroll
      for (int e = 0; e < 4; ++e) o[e] = v[j][e] * rstd * g[e] * (1.f + b[e]) + a[e];
      u32x2 ob; ob[0] = pk2(o[0], o[1]); ob[1] = pk2(o[2], o[3]);
      *(u32x2*)(dst + drow * D + c) = ob;
      if (last) *(f32x4*)(p.out + OUT_SHIFT + (size_t)st * D + c) = o;
    }
  }
}

DEV void fox_prep_tile(const P& p, int tile, char* smem) {
  const int tid = otid(), lane = tid & 63, wid = tid >> 6;
  float* lf = (float*)smem;
  bf16_t* proj = (bf16_t*)(p.ws + O_PROJ);
  const float* pab = (const float*)(p.ws + O_PAB);
  const float* qn = p.in[20]; const float* kn = p.in[21]; const float* fb = p.in[22];
  __syncthreads();
  unsigned uq[4], uk[4], uv[4], nq[4], nk[4], nv[4]; float fr = 0.f, nf = 0.f;
  const float qn0 = qn[lane * 2], qn1 = qn[lane * 2 + 1], kn0 = kn[lane * 2], kn1 = kn[lane * 2 + 1];
  const float fbl = lane < 4 ? fb[lane] : 0.f;
  {
    const bf16_t* pr0 = proj + (size_t)(tile * 128 + wid * 32) * NPROJ;
#pragma unroll
    for (int hd = 0; hd < 4; ++hd) { const int c = hd * 128 + lane * 2; uq[hd] = *(const unsigned*)(pr0 + 2048 + c); uk[hd] = *(const unsigned*)(pr0 + 2560 + c); uv[hd] = *(const unsigned*)(pr0 + 3072 + c); }
    fr = pab[(size_t)(tile * 128 + wid * 32) * 16 + 8 + (lane & 3)];
  }
  for (int rr = wid * 32; rr < wid * 32 + 32; ++rr) {
    const int row = tile * 128 + rr;
    bf16_t* pr = proj + (size_t)row * NPROJ;
    {
      const int rn = (rr + 1 < wid * 32 + 32) ? row + 1 : row;
      const bf16_t* prn = proj + (size_t)rn * NPROJ;
#pragma unroll
      for (int hd = 0; hd < 4; ++hd) { const int c = hd * 128 + lane * 2; nq[hd] = *(const unsigned*)(prn + 2048 + c); nk[hd] = *(const unsigned*)(prn + 2560 + c); nv[hd] = *(const unsigned*)(prn + 3072 + c); }
      nf = pab[(size_t)rn * 16 + 8 + (lane & 3)];
    }
#pragma unroll
    for (int hd = 0; hd < 4; ++hd) {
      const int c = hd * 128 + lane * 2;
      { const float a = bflo(uq[hd]), b = bfhi(uq[hd]);
        const float ss = wave_sum(a * a + b * b); const float rs = rsqrtf(ss * (1.f / 128.f) + 1e-6f) * 0.08838834764831845f * LOG2E;
        *(unsigned*)(pr + 2048 + c) = pk2(a * rs * qn0, b * rs * qn1); }
      { const float a = bflo(uk[hd]), b = bfhi(uk[hd]);
        const float ss = wave_sum(a * a + b * b); const float rs = rsqrtf(ss * (1.f / 128.f) + 1e-6f);
        f32x2 o = {a * rs * kn0, b * rs * kn1};
        *(f32x2*)(p.out + OUT_FK + (size_t)row * 512 + c) = o; }
      { f32x2 o = {bflo(uv[hd]), bfhi(uv[hd])};
        *(f32x2*)(p.out + OUT_FV + (size_t)row * 512 + c) = o; }
    }
    if (lane < 4) {
      const float f = logsigmoidf_(fr + fbl);
      p.out[OUT_LOGF + (size_t)row * 4 + lane] = f;
      lf[rr * 4 + lane] = f;
    }
#pragma unroll
    for (int hd = 0; hd < 4; ++hd) { uq[hd] = nq[hd]; uk[hd] = nk[hd]; uv[hd] = nv[hd]; }
    fr = nf;
  }
  __syncthreads();
  if (tid < 4) {
    float* cl = (float*)(p.ws + O_CL); float run = 0.f;
    for (int rr = 0; rr < 128; ++rr) { run += lf[rr * 4 + tid]; cl[(size_t)(tile * 128 + rr) * 4 + tid] = run; }
    ((float*)(p.ws + O_TOT))[tile * 4 + tid] = run;
  }
}

DEV int img_off128(int l, int k) {
  const int p = perm16(k & 15); const int cidx = (k >> 4) * 2 + (p >> 3);
  return l * 256 + ((cidx ^ (l & 15)) << 4) + (p & 7) * 2;
}
DEV int img_off64(int rowi, int j) {
  const int p = perm16(j & 15); const int cidx = (j >> 4) * 2 + (p >> 3);
  return rowi * 128 + ((cidx ^ ((rowi >> 1) & 7)) << 4) + (p & 7) * 2;
}

struct ConvCtx { const bf16_t* proj; const float* cache; const float* cw; int row0, L, first, stream; };
DEV float conv_raw(const ConvCtx& c, int rr, int ch) {
  if (rr >= 0) return bf2f(c.proj[(size_t)(c.row0 + rr) * NPROJ + ch]);
  if (!c.first) return bf2f(c.proj[(size_t)(c.row0 + rr) * NPROJ + ch]);
  if (c.stream == 0) return 0.f;
  return c.cache[((size_t)(c.stream - 1) * 3 + (3 + rr)) * 1536 + ch];
}

DEV void gdn_prep_item(const P& p, int item, char* smem) {
  const int tid = otid(), lane = tid & 63, wid = tid >> 6;
  const int ci = item >> 2, hd = item & 3;
  ConvCtx cc; cc.proj = (const bf16_t*)(p.ws + O_PROJ); cc.cache = p.in[4]; cc.cw = p.in[16];
  if (ci < 256) { cc.row0 = ci * 64; cc.L = 64; cc.stream = 0; cc.first = ci == 0; }
  else { cc.row0 = TP + (ci - 256) * 16; cc.L = 16; cc.stream = 1 + (ci - 256); cc.first = 1; }
  const int L = cc.L;
  float* ks = (float*)smem;
  float* As = ks + 64 * 132;
  float* sbeta = As + 64 * 68;
  float* sg = sbeta + 64, *sgc = sg + 64, *seg = sgc + 64;
  const float* pab = (const float*)(p.ws + O_PAB);
  char* img = p.ws + O_GIMG + (size_t)item * GIMG_BYTES;
  __syncthreads();
  {
    const int c = tid & 127, half = tid >> 7, ch = 512 + hd * 128 + c;
    const float w0 = cc.cw[ch], w1 = cc.cw[1536 + ch], w2 = cc.cw[2 * 1536 + ch], w3 = cc.cw[3 * 1536 + ch];
    const int rbeg = half * 32;
    float xr[35];
#pragma unroll
    for (int i = 0; i < 3; ++i) { const int rr = rbeg - 3 + i; xr[i] = (rr < L) ? conv_raw(cc, rr, ch) : 0.f; }
#pragma unroll
    for (int i = 3; i < 35; ++i) { const int rr = rbeg - 3 + i; const float t_ = bf2f(cc.proj[(size_t)(cc.row0 + (rr < L ? rr : L - 1)) * NPROJ + ch]); xr[i] = (rr < L) ? t_ : 0.f; }
#pragma unroll
    for (int i = 0; i < 32; ++i) {
      const int rr = rbeg + i; float o = 0.f;
      if (rr < L) o = siluf_(xr[i] * w0 + xr[i + 1] * w1 + xr[i + 2] * w2 + xr[i + 3] * w3);
      ks[rr * 132 + c] = o;
    }
  }
  if (tid < 64) {
    const int rr = tid; float be = 0.f, g = 0.f;
    if (rr < L) {
      const float braw = pab[(size_t)(cc.row0 + rr) * 16 + hd], araw = pab[(size_t)(cc.row0 + rr) * 16 + 4 + hd];
      be = sigmoidf_(braw); g = -__expf(p.in[17][hd]) * softplusf_(araw + p.in[18][hd]);
    }
    sbeta[rr] = be; sg[rr] = g;
  }
  __syncthreads();
  for (int rr = wid * 16; rr < wid * 16 + 16; ++rr) {
    const float a = ks[rr * 132 + lane], b = ks[rr * 132 + lane + 64];
    const float ss = wave_sum(a * a + b * b); const float rs = rsqrtf(ss + 1e-6f);
    ks[rr * 132 + lane] = a * rs; ks[rr * 132 + lane + 64] = b * rs;
  }
  if (tid == 0) {
    float run = 0.f;
    for (int rr = 0; rr < 64; ++rr) { run += sg[rr]; sgc[rr] = run; seg[rr] = __expf(run); }
    ((float*)(p.ws + O_GL))[item] = run;
  }
  __syncthreads();
  {
    const int ti = tid >> 4, tj = tid & 15;
    float acc[4][4];
#pragma unroll
    for (int a = 0; a < 4; ++a)
#pragma unroll
      for (int b = 0; b < 4; ++b) acc[a][b] = 0.f;
    for (int d = 0; d < 128; d += 4) {
      f32x4 ka[4], kb[4];
#pragma unroll
      for (int a = 0; a < 4; ++a) { ka[a] = *(const f32x4*)(ks + (ti + 16 * a) * 132 + d); kb[a] = *(const f32x4*)(ks + (tj + 16 * a) * 132 + d); }
#pragma unroll
      for (int a = 0; a < 4; ++a)
#pragma unroll
        for (int b = 0; b < 4; ++b) acc[a][b] += ka[a][0] * kb[b][0] + ka[a][1] * kb[b][1] + ka[a][2] * kb[b][2] + ka[a][3] * kb[b][3];
    }
#pragma unroll
    for (int a = 0; a < 4; ++a)
#pragma unroll
      for (int b = 0; b < 4; ++b) {
        const int i = ti + 16 * a, j = tj + 16 * b;
        As[i * 68 + j] = (j < i) ? sbeta[i] * acc[a][b] * __expf(sgc[i] - sgc[j]) : 0.f;
      }
  }
  __syncthreads();
  {
    float x[64];
    if (tid < 128) {
      const int c = tid, ch = 1024 + hd * 128 + c;
      const float w0 = cc.cw[ch], w1 = cc.cw[1536 + ch], w2 = cc.cw[2 * 1536 + ch], w3 = cc.cw[3 * 1536 + ch];
      float x0 = conv_raw(cc, -3, ch), x1 = conv_raw(cc, -2, ch), x2 = conv_raw(cc, -1, ch);
#pragma unroll
      for (int rr = 0; rr < 64; ++rr) x[rr] = bf2f(cc.proj[(size_t)(cc.row0 + (rr < L ? rr : L - 1)) * NPROJ + ch]);
#pragma unroll
      for (int rr = 0; rr < 64; ++rr) {
        const float x3 = x[rr];
        x[rr] = (rr < L) ? siluf_(x0 * w0 + x1 * w1 + x2 * w2 + x3 * w3) * sbeta[rr] : 0.f;
        x0 = x1; x1 = x2; x2 = x3;
      }
    } else {
      const int c = tid - 128;
#pragma unroll
      for (int rr = 0; rr < 64; ++rr) x[rr] = ks[rr * 132 + c] * sbeta[rr] * seg[rr];
    }
#pragma unroll
    for (int i = 1; i < 64; ++i) {
      float a = x[i];
#pragma unroll
      for (int j4 = 0; j4 < (i + 3) / 4; ++j4) {
        const f32x4 av = *(const f32x4*)(As + i * 68 + j4 * 4);
        a -= av[0] * x[4 * j4 + 0];
        if (4 * j4 + 1 < i) a -= av[1] * x[4 * j4 + 1];
        if (4 * j4 + 2 < i) a -= av[2] * x[4 * j4 + 2];
        if (4 * j4 + 3 < i) a -= av[3] * x[4 * j4 + 3];
      }
      x[i] = a;
      __builtin_amdgcn_sched_barrier(0);
    }
    if (tid < 128) {
      const int c = tid, w = c >> 5, ll = c & 31;
      bf16_t* uvb = (bf16_t*)(img + 57344) + (w * 128 + ll) * 16;
#pragma unroll
      for (int rr = 0; rr < 64; ++rr) {
        const int mt = rr >> 5, r5 = rr & 31, hh = (r5 >> 2) & 1, ii = (r5 & 3) + 4 * (r5 >> 3);
        uvb[(mt * 64 + 32 * hh) * 16 + ii] = f2bf(x[rr]);
        if ((rr & 7) == 7) __builtin_amdgcn_sched_barrier(0);
      }
    } else {
      const int c = tid - 128;
      const int pp = perm16(c & 15), cidx = (c >> 4) * 2 + (pp >> 3);
#pragma unroll
      for (int q = 0; q < 16; ++q) {
        char* bq = img + q * 256 + ((cidx ^ q) << 4) + (pp & 7) * 2;
#pragma unroll
        for (int g = 0; g < 4; ++g) *(bf16_t*)(bq + g * 4096) = f2bf(-x[16 * g + q]);
        __builtin_amdgcn_sched_barrier(0);
      }
    }
  }
  __syncthreads();
  float* qs = As;
  for (int hq = 0; hq < 2; ++hq) {
    {
      const int c = tid & 127, sub = tid >> 7, ch = hd * 128 + c;
      const float w0 = cc.cw[ch], w1 = cc.cw[1536 + ch], w2 = cc.cw[2 * 1536 + ch], w3 = cc.cw[3 * 1536 + ch];
      const int rbeg = hq * 32 + sub * 16;
      float xr[19];
#pragma unroll
      for (int i = 0; i < 3; ++i) { const int rr = rbeg - 3 + i; xr[i] = (rr < L) ? conv_raw(cc, rr, ch) : 0.f; }
#pragma unroll
      for (int i = 3; i < 19; ++i) { const int rr = rbeg - 3 + i; const float t_ = bf2f(cc.proj[(size_t)(cc.row0 + (rr < L ? rr : L - 1)) * NPROJ + ch]); xr[i] = (rr < L) ? t_ : 0.f; }
#pragma unroll
      for (int i = 0; i < 16; ++i) {
        const int rr = rbeg + i; float o = 0.f;
        if (rr < L) o = siluf_(xr[i] * w0 + xr[i + 1] * w1 + xr[i + 2] * w2 + xr[i + 3] * w3);
        qs[(rr - hq * 32) * 132 + c] = o;
      }
    }
    __syncthreads();
    for (int lr = wid * 8; lr < wid * 8 + 8; ++lr) {
      const float a = qs[lr * 132 + lane], b = qs[lr * 132 + lane + 64];
      const float ss = wave_sum(a * a + b * b); const float rs = rsqrtf(ss + 1e-6f) * 0.08838834764831845f;
      qs[lr * 132 + lane] = a * rs; qs[lr * 132 + lane + 64] = b * rs;
    }
    __syncthreads();
    {
      const int c = tid & 127, sub = tid >> 7;
      for (int i = 0; i < 16; ++i) {
        const int lr = sub * 16 + i, rr = hq * 32 + lr;
        *(bf16_t*)(img + 16384 + img_off128(rr, c)) = f2bf(qs[lr * 132 + c] * seg[rr]);
      }
      const int ti = tid >> 4, tj = tid & 15;
      float acc[2][4];
#pragma unroll
      for (int a = 0; a < 2; ++a)
#pragma unroll
        for (int b = 0; b < 4; ++b) acc[a][b] = 0.f;
      for (int d = 0; d < 128; d += 4) {
        f32x4 qa[2], kb[4];
#pragma unroll
        for (int a = 0; a < 2; ++a) qa[a] = *(const f32x4*)(qs + (ti + 16 * a) * 132 + d);
#pragma unroll
        for (int b = 0; b < 4; ++b) kb[b] = *(const f32x4*)(ks + (tj + 16 * b) * 132 + d);
#pragma unroll
        for (int a = 0; a < 2; ++a)
#pragma unroll
          for (int b = 0; b < 4; ++b) acc[a][b] += qa[a][0] * kb[b][0] + qa[a][1] * kb[b][1] + qa[a][2] * kb[b][2] + qa[a][3] * kb[b][3];
      }
#pragma unroll
      for (int a = 0; a < 2; ++a)
#pragma unroll
        for (int b = 0; b < 4; ++b) {
          const int i = hq * 32 + ti + 16 * a, j = tj + 16 * b;
          const float v = (j <= i) ? acc[a][b] * __expf(sgc[i] - sgc[j]) : 0.f;
          *(bf16_t*)(img + 32768 + img_off64(i, j)) = f2bf(v);
        }
    }
    __syncthreads();
  }
  {
    const int c = tid & 127, lb = (tid >> 7) * 32;
    const float glast = sgc[63];
    for (int i = 0; i < 32; ++i) {
      const int l = lb + i;
      *(bf16_t*)(img + 40960 + img_off64(c, l)) = f2bf(ks[l * 132 + c] * __expf(glast - sgc[l]));
    }
  }
}

DEV void gdn_scan_item(const P& p, int sitem, char* smem) {
  const int tid = otid(), lane = tid & 63, w = tid >> 6, r = lane & 31, h = lane >> 5;
  int stream, hd, half, nchunks, item0, row0, L;
  if (sitem < 8) { stream = 0; hd = sitem >> 1; half = sitem & 1; nchunks = 256; item0 = hd; row0 = 0; L = 64; }
  else { const int n = sitem - 8; const int b = n >> 3; hd = (n >> 1) & 3; half = n & 1; stream = 1 + b; nchunks = 1; item0 = (256 + b) * 4 + hd; row0 = TP + 16 * b; L = 16; }
  __syncthreads();
  if (w >= 2) {
    const unsigned lo = (unsigned)(tid - 128) * 16u;
    u32x4 ra[28];
#define GS_LOAD(REG, C) { const char* img_ = p.ws + O_GIMG + (size_t)(item0 + (C) * 4) * GIMG_BYTES; _Pragma("unroll") for (int i = 0; i < 28; ++i) REG[i] = *(const u32x4*)((img_ + 2048 * i) + lo); }
#define GS_STORE(REG) { _Pragma("unroll") for (int i = 0; i < 28; ++i) *(u32x4*)(smem + 2048 * i + lo) = REG[i]; }
    float* orawl = (float*)(p.ws + O_ORAW);
    f32x4 ov_[8];
#define GS_OREAD() { _Pragma("unroll") for (int i = 0; i < 8; ++i) ov_[i] = *(const f32x4*)(smem + 2048u * i + lo); }
#define GS_OWRITE(CC) { _Pragma("unroll") for (int i = 0; i < 8; ++i) { const unsigned B_ = 2048u * i + lo; const int w_ = B_ >> 13, row_ = (B_ & 8191u) >> 7, c4_ = ((B_ & 127u) >> 4) * 4; \
        if (row_ < L) *(f32x4*)(orawl + (size_t)(row0 + (CC) * 64 + row_) * 512 + hd * 128 + 32 * (2 * half + w_) + c4_) = ov_[i]; } }
    GS_LOAD(ra, 0)
    for (int c = 0; c < nchunks; ++c) {
      LBAR();
      if (c > 0) GS_OREAD()
#pragma unroll
      for (int i = 0; i < 16; ++i) *(u32x4*)(smem + 2048 * i + lo) = ra[i];
      LBAR();
      if (c > 0) GS_OWRITE(c - 1)
#pragma unroll
      for (int i = 16; i < 28; ++i) *(u32x4*)(smem + 2048 * i + lo) = ra[i];
      if (c + 1 < nchunks) GS_LOAD(ra, c + 1)
      LBAR();
    }
    LBAR();
    GS_OREAD()
    GS_OWRITE(nchunks - 1)
  } else {
    const int vs = 2 * half + w;
    f32x16 S[4];
#pragma unroll
    for (int kt = 0; kt < 4; ++kt)
#pragma unroll
      for (int i = 0; i < 16; ++i) {
        float v = 0.f;
        if (stream > 0) v = p.in[5][(((size_t)(stream - 1) * 4 + hd) * 128 + 32 * kt + crow(i, h)) * 128 + 32 * vs + r];
        S[kt][i] = v;
      }
    const float* gl = (const float*)(p.ws + O_GL);
    float* oraw = (float*)(p.ws + O_ORAW);
    const unsigned uoff = (unsigned)(vs * 128 + lane) * 32u;
    u32x4 pu[4]; float gln;
    int a1[8], a2[4];
#pragma unroll
    for (int q = 0; q < 8; ++q) a1[q] = r * 256 + (((2 * q + h) ^ (r & 15)) << 4);
#pragma unroll
    for (int q = 0; q < 4; ++q) a2[q] = 32768 + r * 128 + (((2 * q + h) ^ ((r >> 1) & 7)) << 4);
    {
      const char* img = p.ws + O_GIMG + (size_t)item0 * GIMG_BYTES;
      gln = gl[item0];
#pragma unroll
      for (int mt = 0; mt < 2; ++mt) { pu[2 * mt] = *(const u32x4*)((img + 57344 + mt * 2048) + uoff); pu[2 * mt + 1] = *(const u32x4*)((img + 57344 + mt * 2048 + 16) + uoff); }
    }
    for (int c = 0; c < nchunks; ++c) {
      const int item = item0 + c * 4;
      LBAR();
      f32x16 U[2], O[2];
#pragma unroll
      for (int mt = 0; mt < 2; ++mt) {
#pragma unroll
        for (int e = 0; e < 4; ++e) { U[mt][2 * e] = bflo(pu[2 * mt][e]); U[mt][2 * e + 1] = bfhi(pu[2 * mt][e]); U[mt][8 + 2 * e] = bflo(pu[2 * mt + 1][e]); U[mt][8 + 2 * e + 1] = bfhi(pu[2 * mt + 1][e]); }
#pragma unroll
        for (int i = 0; i < 16; ++i) O[mt][i] = 0.f;
      }
      const float gamma = __expf(gln);
      if (c + 1 < nchunks) {
        const char* img = p.ws + O_GIMG + (size_t)(item + 4) * GIMG_BYTES;
        gln = gl[item + 4];
#pragma unroll
        for (int mt = 0; mt < 2; ++mt) { pu[2 * mt] = *(const u32x4*)((img + 57344 + mt * 2048) + uoff); pu[2 * mt + 1] = *(const u32x4*)((img + 57344 + mt * 2048 + 16) + uoff); }
      }
      LBAR();
      bf16x8 FA[8], FB[8];
#define LD1(F, KT) { _Pragma("unroll") for (int s_ = 0; s_ < 2; ++s_) { const char* b_ = smem + a1[2 * (KT) + s_]; \
        F[4 * s_ + 0] = *(const bf16x8*)(b_); F[4 * s_ + 1] = *(const bf16x8*)(b_ + 16384); F[4 * s_ + 2] = *(const bf16x8*)(b_ + 8192); F[4 * s_ + 3] = *(const bf16x8*)(b_ + 8192 + 16384); } }
#define MM1(F, KT) { _Pragma("unroll") for (int s_ = 0; s_ < 2; ++s_) { const bf16x8 sf_ = pack8(S[KT], s_); \
        U[0] = MFMA32(F[4 * s_ + 0], sf_, U[0]); O[0] = MFMA32(F[4 * s_ + 1], sf_, O[0]); U[1] = MFMA32(F[4 * s_ + 2], sf_, U[1]); O[1] = MFMA32(F[4 * s_ + 3], sf_, O[1]); } }
#define LD2(F) { _Pragma("unroll") for (int q_ = 0; q_ < 4; ++q_) { const char* b_ = smem + a2[q_]; F[2 * q_] = *(const bf16x8*)(b_); F[2 * q_ + 1] = *(const bf16x8*)(b_ + 4096); } }
#define LD3(F, M2) { _Pragma("unroll") for (int s_ = 0; s_ < 2; ++s_) { const char* b_ = smem + 8192 + a2[2 * (M2) + s_]; _Pragma("unroll") for (int kt_ = 0; kt_ < 4; ++kt_) F[4 * s_ + kt_] = *(const bf16x8*)(b_ + 4096 * kt_); } }
#define MM3(F, M2) { _Pragma("unroll") for (int s_ = 0; s_ < 2; ++s_) { _Pragma("unroll") for (int kt_ = 0; kt_ < 4; ++kt_) S[kt_] = MFMA32(F[4 * s_ + kt_], uf[M2][s_], S[kt_]); } }
#define SB __builtin_amdgcn_sched_barrier(0);
      LD1(FA, 0) SB
      LD1(FB, 1) SB MM1(FA, 0) SB
      LD1(FA, 2) SB MM1(FB, 1) SB
      LD1(FB, 3) SB MM1(FA, 2) SB
      MM1(FB, 3) SB
      LBAR();
      LD2(FA) SB
      bf16x8 uf[2][2];
#pragma unroll
      for (int mt = 0; mt < 2; ++mt)
#pragma unroll
        for (int s = 0; s < 2; ++s) uf[mt][s] = pack8(U[mt], s);
      LD3(FB, 0) SB
#pragma unroll
      for (int q = 0; q < 4; ++q) { O[0] = MFMA32(FA[2 * q], uf[q >> 1][q & 1], O[0]); O[1] = MFMA32(FA[2 * q + 1], uf[q >> 1][q & 1], O[1]); }
      {
        float* os_ = (float*)smem + w * 2048 + 4 * h * 32 + r;
#pragma unroll
        for (int mt = 0; mt < 2; ++mt)
#pragma unroll
          for (int i = 0; i < 16; ++i) os_[(32 * mt + (i & 3) + 8 * (i >> 2)) * 32] = O[mt][i];
      }
#pragma unroll
      for (int kt = 0; kt < 4; ++kt)
#pragma unroll
        for (int i = 0; i < 16; ++i) S[kt][i] *= gamma;
      SB
      LD3(FA, 1) SB MM3(FB, 0) SB
      MM3(FA, 1) SB
    }
    LBAR();
    float* dout = p.out + OUT_DELTA + ((size_t)stream * 4 + hd) * 128 * 128;
#pragma unroll
    for (int kt = 0; kt < 4; ++kt)
#pragma unroll
      for (int i = 0; i < 16; ++i) dout[(size_t)(32 * kt + crow(i, h)) * 128 + 32 * vs + r] = S[kt][i];
  }
}

DEV void fox_attn_item(const P& p, int aitem, char* smem) {
  const int tid = otid(), lane = tid & 63, w = tid >> 6, r = lane & 31, h = lane >> 5;
  int hd, b = 0, qrow0, nq, nkeys, qpos0, ntiles; bool dec;
  if (aitem < 32) { dec = true; b = aitem >> 2; hd = aitem & 3; qrow0 = TP + 16 * b; nq = 16; nkeys = 4112; qpos0 = 4096; ntiles = 129; }
  else { const int n = aitem - 32; dec = false; hd = n & 3; const int qb = 127 - (n >> 2); qrow0 = 128 * qb; nq = 128; nkeys = TP; qpos0 = qrow0; ntiles = ((qrow0 + 127) >> 5) + 1; }
  char* sK = smem; char* sV = smem + 8192;
  float* sck = (float*)(smem + 16384);
  float* sbase = (float*)(smem + 16640);
  float* sred = (float*)(smem + 16640 + 4352 * 4);
  const float* fk = p.out + OUT_FK; const float* fv = p.out + OUT_FV;
  const float* cl = (const float*)(p.ws + O_CL);
  __syncthreads();
  if (!dec) {
    if (tid == 0) { const float* tot = (const float*)(p.ws + O_TOT); float run = 0.f; for (int t = 0; t < 128; ++t) { sbase[t] = run; run += tot[t * 4 + hd]; } sbase[128] = run; }
  } else {
    float run = 0.f;
#pragma unroll 1
    for (int e = 0; e < 17; ++e) {
      const int j = tid * 17 + e; float v = 0.f;
      if (j < 4096) v = p.in[8][((size_t)b * 4096 + j) * 4 + hd];
      else if (j < 4112) v = p.out[OUT_LOGF + (size_t)(TP + 16 * b + (j - 4096)) * 4 + hd];
      run += v; sbase[j] = run;
    }
    sred[tid] = run;
    __syncthreads();
    if (tid == 0) { float a = 0.f; for (int t = 0; t < 256; ++t) { const float x = sred[t]; sred[t] = a; a += x; } }
    __syncthreads();
    const float basev = sred[tid];
#pragma unroll 1
    for (int e = 0; e < 17; ++e) sbase[tid * 17 + e] += basev;
  }
  __syncthreads();
  int kt_lo = 0;
  {
    const float thr = ((const float*)(p.ws + O_CTR))[40];
    if (!dec) {
      const float ci0 = sbase[qrow0 >> 7] + cl[(size_t)qrow0 * 4 + hd];
      int tb = 0;
      while (tb < (qrow0 >> 7) && ci0 - sbase[tb + 1] < -thr) ++tb;
      kt_lo = 4 * tb;
    } else {
      const float ci0 = sbase[4096];
      while (kt_lo < 128 && ci0 - sbase[32 * kt_lo + 31] < -thr) ++kt_lo;
    }
  }
  const bool active = 32 * w < nq;
  const int qi = 32 * w + r;
  const bool qvalid = qi < nq;
  const int qrow = qrow0 + (qvalid ? qi : 0);
  const int qpos = qpos0 + qi;
  float cq;
  if (!dec) cq = sbase[qpos >> 7] + cl[(size_t)qpos * 4 + hd]; else cq = sbase[qvalid ? qpos : 4096];
  cq *= LOG2E;
  bf16x8 qf[8];
  {
    const bf16_t* qp = (const bf16_t*)(p.ws + O_PROJ) + (size_t)qrow * NPROJ + 2048 + hd * 128 + 8 * h;
#pragma unroll
    for (int ks = 0; ks < 8; ++ks) qf[ks] = *(const bf16x8*)(qp + 16 * ks);
  }
  f32x16 O[4];
#pragma unroll
  for (int dt = 0; dt < 4; ++dt)
#pragma unroll
    for (int i = 0; i < 16; ++i) O[dt][i] = 0.f;
  float m = -1e30f, lsum = 0.f;
  const int kkl = tid >> 3, ksub = tid & 7;
  const int vkl = tid & 31, vdg = tid >> 5;
  f32x4 kreg[4], vreg[4]; float ckreg = 0.f;
  auto krow_ptr = [&](const float* base_out, const float* cache, int j) -> const float* {
    j = j < nkeys ? j : nkeys - 1;
    const float* p_new = base_out + ((size_t)(dec ? TP + 16 * b + (j - 4096) : j) * 4 + hd) * 128;
    const float* p_old = cache + (((size_t)b * 4096 + (j < 4096 ? j : 0)) * 4 + hd) * 128;
    return (dec && j < 4096) ? p_old : p_new;
  };
  auto gload = [&](int kt) {
    const float* kp = krow_ptr(fk, p.in[6], kt * 32 + kkl);
    const float* vp = krow_ptr(fv, p.in[7], kt * 32 + vkl);
#pragma unroll
    for (int e = 0; e < 4; ++e) {
      kreg[e] = *(const f32x4*)(kp + 16 * ksub + 4 * e);
      vreg[e] = *(const f32x4*)(vp + 16 * vdg + 4 * e);
    }
    if (tid < 32) {
      const int j = kt * 32 + tid;
      float c = 0.f;
      if (j < nkeys) c = dec ? sbase[j] : sbase[j >> 7] + cl[(size_t)j * 4 + hd];
      ckreg = c * LOG2E;
    }
  };
  gload(kt_lo);
  for (int kt = kt_lo; kt < ntiles; ++kt) {
    __syncthreads();
#pragma unroll
    for (int e = 0; e < 2; ++e) {
      const int cidx = ksub * 2 + e;
      u32x4 o; o[0] = pk2(kreg[2 * e][0], kreg[2 * e][1]); o[1] = pk2(kreg[2 * e][2], kreg[2 * e][3]);
      o[2] = pk2(kreg[2 * e + 1][0], kreg[2 * e + 1][1]); o[3] = pk2(kreg[2 * e + 1][2], kreg[2 * e + 1][3]);
      *(u32x4*)(sK + kkl * 256 + ((cidx ^ (kkl & 15)) << 4)) = o;
    }
    {
      const int pos = (vkl & ~15) + perm16(vkl & 15);
#pragma unroll
      for (int e = 0; e < 4; ++e)
#pragma unroll
        for (int f = 0; f < 4; ++f) {
          const int d = 16 * vdg + 4 * e + f;
          *(bf16_t*)(sV + d * 64 + (((pos >> 3) ^ ((d >> 2) & 3)) << 4) + (pos & 7) * 2) = f2bf(vreg[e][f]);
        }
    }
    if (tid < 32) sck[tid] = ckreg;
    __syncthreads();
    if (kt + 1 < ntiles) gload(kt + 1);
    if (active && (kt * 32 <= qpos0 + 32 * w + 31)) {
      f32x16 S;
#pragma unroll
      for (int i = 0; i < 16; ++i) S[i] = 0.f;
#pragma unroll
      for (int ks = 0; ks < 8; ++ks) {
        const bf16x8 a = *(const bf16x8*)(sK + r * 256 + (((2 * ks + h) ^ (r & 15)) << 4));
        S = MFMA32(a, qf[ks], S);
      }
      __builtin_amdgcn_sched_barrier(0);
      float mx = -INFINITY;
#pragma unroll
      for (int g = 0; g < 4; ++g) {
        const f32x4 ck4 = *(const f32x4*)(sck + 8 * g + 4 * h);
#pragma unroll
        for (int e = 0; e < 4; ++e) {
          const int i = 4 * g + e;
          const int kabs = kt * 32 + 8 * g + 4 * h + e;
          float sv = S[i] + (cq - ck4[e]);
          sv = (kabs <= qpos) ? sv : -INFINITY;
          S[i] = sv; mx = fmaxf(mx, sv);
        }
      }
      mx = fmaxf(mx, __shfl_xor(mx, 32));
      const float mn = fmaxf(m, mx);
      const float alpha = __builtin_amdgcn_exp2f(m - mn);
      m = mn;
      float ps = 0.f;
#pragma unroll
      for (int i = 0; i < 16; ++i) { const float pv = __builtin_amdgcn_exp2f(S[i] - mn); S[i] = pv; ps += pv; }
      lsum = lsum * alpha + ps;
#pragma unroll
      for (int dt = 0; dt < 4; ++dt)
#pragma unroll
        for (int i = 0; i < 16; ++i) O[dt][i] *= alpha;
      bf16x8 pf[2];
#pragma unroll
      for (int s = 0; s < 2; ++s) pf[s] = pack8(S, s);
      __builtin_amdgcn_sched_barrier(0);
#pragma unroll
      for (int dt = 0; dt < 4; ++dt)
#pragma unroll
        for (int s = 0; s < 2; ++s) {
          const int d = 32 * dt + r;
          const bf16x8 a = *(const bf16x8*)(sV + d * 64 + (((2 * s + h) ^ ((d >> 2) & 3)) << 4));
          O[dt] = MFMA32(a, pf[s], O[dt]);
        }
    }
  }
  if (active) {
    const float lt = lsum + __shfl_xor(lsum, 32);
    const float inv = 1.f / lt;
    if (qvalid) {
      bf16_t* op = (bf16_t*)(p.ws + O_R1) + (size_t)qrow * D + 512 + hd * 128;
#pragma unroll
      for (int dt = 0; dt < 4; ++dt)
#pragma unroll
        for (int g = 0; g < 4; ++g) {
          u32x2 o; o[0] = pk2(O[dt][4 * g] * inv, O[dt][4 * g + 1] * inv); o[1] = pk2(O[dt][4 * g + 2] * inv, O[dt][4 * g + 3] * inv);
          *(u32x2*)(op + 32 * dt + 8 * g + 4 * h) = o;
        }
    }
  }
}

DEV void wkv_scan_item(const P& p, int item, char* smem) {
  const int tid = otid(), lane = tid & 63, w = tid >> 6;
  int stream, hd, rg, row0, nsteps;
  if (item < 256) { stream = 0; hd = item >> 4; rg = item & 15; row0 = 0; nsteps = TP; }
  else { const int n = item - 256; const int b = n >> 8; stream = 1 + b; hd = (n >> 4) & 15; rg = n & 15; row0 = TP + 16 * b; nsteps = 16; }
  constexpr int BUF = 6 * 1024 + 16 * 8;
  float* bufs = (float*)smem;
  const bf16_t* rkv = (const bf16_t*)(p.ws + O_RKVB);
  const float* dec = (const float*)(p.ws + O_DEC);
  const bf16_t* ab = (const bf16_t*)(p.ws + O_AB);
  bf16_t* yraw = (bf16_t*)(p.ws + O_R1);
  const int nch = nsteps >> 4;
  __syncthreads();
  if (w > 0) {
    const int slot0 = tid - 64;
    const bool two = slot0 < 64;
    u32x2 rr_[4][2], kr_[4][2], vr_[4][2], ar_[4][2], kn_[4][2]; f32x4 dr_[4][2];
#define WKV_GLOAD(SET, C) { if ((C) < nch) { _Pragma("unroll") for (int q = 0; q < 2; ++q) { if (q == 1 && !two) break; \
        const int slot = slot0 + 192 * q; const int ltok = slot >> 4, ch = hd * 64 + (slot & 15) * 4; const size_t row = row0 + (C) * 16 + ltok; \
        rr_[SET][q] = *(const u32x2*)(rkv + row * 3072 + ch); kr_[SET][q] = *(const u32x2*)(rkv + row * 3072 + 1024 + ch); vr_[SET][q] = *(const u32x2*)(rkv + row * 3072 + 2048 + ch); \
        kn_[SET][q] = *(const u32x2*)(rkv + (row + 1) * 3072 + 1024 + ch); \
        ar_[SET][q] = *(const u32x2*)(ab + row * 1024 + ch); dr_[SET][q] = *(const f32x4*)(dec + row * 1024 + ch); } } }
#define WKV_PREP(SET, BI) { float* bp = bufs + (BI) * BUF; _Pragma("unroll") for (int q = 0; q < 2; ++q) { if (q == 1 && !two) break; \
        const int slot = slot0 + 192 * q; const int ltok = slot >> 4, lc4 = (slot & 15) * 4, ch = hd * 64 + lc4; \
        const f32x4 kkw = *(const f32x4*)(p.in[42] + ch), kaw = *(const f32x4*)(p.in[43] + ch); \
        const f32x4 r4 = {bflo(rr_[SET][q][0]), bfhi(rr_[SET][q][0]), bflo(rr_[SET][q][1]), bfhi(rr_[SET][q][1])}; \
        const f32x4 k4 = {bflo(kr_[SET][q][0]), bfhi(kr_[SET][q][0]), bflo(kr_[SET][q][1]), bfhi(kr_[SET][q][1])}; \
        const f32x4 v4 = {bflo(vr_[SET][q][0]), bfhi(vr_[SET][q][0]), bflo(vr_[SET][q][1]), bfhi(vr_[SET][q][1])}; \
        const f32x4 a4 = {bflo(ar_[SET][q][0]), bfhi(ar_[SET][q][0]), bflo(ar_[SET][q][1]), bfhi(ar_[SET][q][1])}; \
        const f32x4 n4 = {bflo(kn_[SET][q][0]), bfhi(kn_[SET][q][0]), bflo(kn_[SET][q][1]), bfhi(kn_[SET][q][1])}; \
        f32x4 kk4 = k4 * kkw; float ss = kk4[0] * kk4[0] + kk4[1] * kk4[1] + kk4[2] * kk4[2] + kk4[3] * kk4[3]; ss = row16_sum(ss); \
        const float rs = rsqrtf(ss + 1e-6f); kk4 = kk4 * rs; \
        f32x4 kn4 = n4 * kkw; float sn = kn4[0] * kn4[0] + kn4[1] * kn4[1] + kn4[2] * kn4[2] + kn4[3] * kn4[3]; sn = row16_sum(sn); \
        const float rn = rsqrtf(sn + 1e-6f); kn4 = kn4 * rn; \
        f32x4 kp4, b4, z4; float be = 0.f, ka_ = 0.f; \
        _Pragma("unroll") for (int e = 0; e < 4; ++e) { kp4[e] = k4[e] * (1.f + (a4[e] - 1.f) * kaw[e]); b4[e] = -kk4[e] * a4[e]; z4[e] = dr_[SET][q][e] * kn4[e]; be += b4[e] * kn4[e]; ka_ += kp4[e] * kn4[e]; } \
        be = row16_sum(be); ka_ = row16_sum(ka_); \
        *(f32x4*)(bp + 0 * 1024 + ltok * 64 + lc4) = r4; *(f32x4*)(bp + 1 * 1024 + ltok * 64 + lc4) = dr_[SET][q]; \
        *(f32x4*)(bp + 2 * 1024 + ltok * 64 + lc4) = kp4; *(f32x4*)(bp + 3 * 1024 + ltok * 64 + lc4) = kk4; *(f32x4*)(bp + 4 * 1024 + ltok * 64 + lc4) = b4; \
        *(f32x4*)(bp + 5 * 1024 + ltok * 64 + lc4) = z4; \
        if ((slot & 15) == rg) *(f32x4*)(bp + 6 * 1024 + ltok * 8) = v4; \
        if ((slot & 15) == 0) { f32x2 bk_ = {be, ka_}; *(f32x2*)(bp + 6 * 1024 + ltok * 8 + 4) = bk_; } } }
    WKV_GLOAD(0, 0) WKV_GLOAD(1, 1) WKV_GLOAD(2, 2) WKV_GLOAD(3, 3)
    WKV_PREP(0, 0)
    WKV_GLOAD(0, 4)
    LBAR();
    for (int c0 = 0; c0 < nch; c0 += 4) {
      { const int c = c0 + 0; if (c < nch) { if (c + 1 < nch) { WKV_PREP(1, 1) WKV_GLOAD(1, c + 5) } LBAR(); } }
      { const int c = c0 + 1; if (c < nch) { if (c + 1 < nch) { WKV_PREP(2, 0) WKV_GLOAD(2, c + 5) } LBAR(); } }
      { const int c = c0 + 2; if (c < nch) { if (c + 1 < nch) { WKV_PREP(3, 1) WKV_GLOAD(3, c + 5) } LBAR(); } }
      { const int c = c0 + 3; if (c < nch) { if (c + 1 < nch) { WKV_PREP(0, 0) WKV_GLOAD(0, c + 5) } LBAR(); } }
    }
  } else {
    const int rowl = lane >> 4, myrow = 4 * rg + rowl, c4 = (lane & 15) * 4;
    f32x4 st = {0.f, 0.f, 0.f, 0.f};
    if (stream > 0) st = *(const f32x4*)(p.in[10] + (((size_t)(stream - 1) * 16 + hd) * 64 + myrow) * 64 + c4);
    f32x2 slo = {st[0], st[1]}, shi = {st[2], st[3]};
    LBAR();
    float sa;
    { const f32x4 kk0 = *(const f32x4*)(bufs + 3 * 1024 + c4); sa = row16_sum(st[0] * kk0[0] + st[1] * kk0[1] + st[2] * kk0[2] + st[3] * kk0[3]); }
    for (int c = 0; c < nch; ++c) {
      const float* bp = bufs + (c & 1) * BUF;
      const float* bq = bp + c4;
      const float* bv = bp + 6 * 1024 + rowl;
      const float* bk = bp + 6 * 1024 + 4;
      float ykeep = 0.f, yprev = 0.f;
      f32x4 Z[16], W[16], NB[16], K[16], R[16]; float V[16]; f32x2 BK[16];
#define WLD(T) { Z[T] = *(const f32x4*)(bq + 5 * 1024 + (T) * 64); W[T] = *(const f32x4*)(bq + 1 * 1024 + (T) * 64); NB[T] = *(const f32x4*)(bq + 4 * 1024 + (T) * 64); \
        K[T] = *(const f32x4*)(bq + 2 * 1024 + (T) * 64); R[T] = *(const f32x4*)(bq + 0 * 1024 + (T) * 64); V[T] = bv[(T) * 8]; BK[T] = *(const f32x2*)(bk + (T) * 8); }
      WLD(0) WLD(1) WLD(2)
#pragma unroll
      for (int t = 0; t < 16; ++t) {
        if (t + 3 < 16) WLD(t + 3)
        __builtin_amdgcn_sched_barrier(0);
        const f32x4 z4 = Z[t], w4 = W[t], nb4 = NB[t], k4 = K[t], r4 = R[t]; const float vv = V[t]; const f32x2 bk2 = BK[t];
        const f32x2 zlo = {z4[0], z4[1]}, zhi = {z4[2], z4[3]}, wlo = {w4[0], w4[1]}, whi = {w4[2], w4[3]};
        const f32x2 nblo = {nb4[0], nb4[1]}, nbhi = {nb4[2], nb4[3]}, klo = {k4[0], k4[1]}, khi = {k4[2], k4[3]}, rlo = {r4[0], r4[1]}, rhi = {r4[2], r4[3]};
        f32x2 pp = slo * zlo; pp = shi * zhi + pp;
        float pr = pp[0] + pp[1];
        const f32x2 vklo = klo * vv, vkhi = khi * vv;
        const f32x2 tlo = nblo * sa + vklo, thi = nbhi * sa + vkhi;
        slo = slo * wlo + tlo; shi = shi * whi + thi;
        const float cnext = sa * bk2[0] + vv * bk2[1];
        pr = row16_sum(pr);
        if (t > 0) { const float yr = row16_sum(yprev); ykeep = ((lane & 15) == t - 1) ? yr : ykeep; }
        f32x2 qq = slo * rlo; qq = shi * rhi + qq;
        yprev = qq[0] + qq[1];
        sa = pr + cnext;
      }
      { const float yr = row16_sum(yprev); ykeep = ((lane & 15) == 15) ? yr : ykeep; }
      yraw[(size_t)(row0 + c * 16 + (lane & 15)) * 1024 + hd * 64 + myrow] = f2bf(ykeep);
      LBAR();
    }
    st = (f32x4){slo[0], slo[1], shi[0], shi[1]};
    *(f32x4*)(p.out + OUT_WKV + (((size_t)stream * 16 + hd) * 64 + myrow) * 64 + c4) = st;
  }
}

#define XB_TMO      128
#define XB_XCNT(j)  (256  + 64 * (j))
#define XB_XSUB(j)  (1280 + 64 * (j))
#define XB_XGEN(j)  (2304 + 64 * (j))
#define XB_TOP      3328
#define XB_TOPGEN   3392
#define XCD_BAR_WORDS 3456
#define XB_SPIN_CAP (1u << 20)
#define LAS3 __attribute__((address_space(3)))
DEV unsigned xb_ld(unsigned* p) { return __hip_atomic_load(p, __ATOMIC_RELAXED, __HIP_MEMORY_SCOPE_AGENT); }
DEV unsigned xb_add(unsigned* p, unsigned v) { return __hip_atomic_fetch_add(p, v, __ATOMIC_RELAXED, __HIP_MEMORY_SCOPE_AGENT); }
DEV unsigned xb_xcc_id() { return (unsigned)__builtin_amdgcn_s_getreg((3 << 11) | 20) & 0xFu; }
#define XB_SPIN(cond, bar) do { unsigned _sp = 0; while (cond) { __builtin_amdgcn_s_sleep(1); \
    if ((++_sp & 255u) == 0u) { if (xb_ld(&(bar)[XB_TMO])) break; if (_sp > XB_SPIN_CAP) { atomicAdd(&(bar)[XB_TMO], 1u); break; } } } } while (0)
struct XcdBarrier { unsigned* bar; unsigned x; volatile LAS3 unsigned* st; };
DEV XcdBarrier xcd_barrier_post(unsigned* bar, volatile LAS3 unsigned* st) {
  XcdBarrier b; b.bar = bar; b.x = xb_xcc_id(); b.st = st;
  if (threadIdx.x == 0) (void)xb_add(&bar[XB_XCNT(b.x)], 1u);
  return b;
}
DEV void xcd_barrier_complete(unsigned* bar, unsigned x, unsigned& nloc, unsigned& nx) {
  const unsigned G = gridDim.x;
  unsigned sum, cnt, mine, sp = 0u;
  for (;;) {
    sum = 0u; cnt = 0u; mine = 0u;
#pragma unroll
    for (unsigned j = 0; j < 16; ++j) { const unsigned c = xb_ld(&bar[XB_XCNT(j)]); sum += c; cnt += (c > 0u) ? 1u : 0u; mine = (j == x) ? c : mine; }
    if (sum == G) break;
    __builtin_amdgcn_s_sleep(1);
    if ((++sp & 255u) == 0u) { if (xb_ld(&bar[XB_TMO])) break; if (sp > XB_SPIN_CAP) { atomicAdd(&bar[XB_TMO], 1u); break; } }
  }
  nloc = mine > 0u ? mine : 1u; nx = cnt > 0u ? cnt : 1u;
}
DEV void xcd_barrier(const XcdBarrier& b) {
  asm volatile("s_waitcnt vmcnt(0)" ::: "memory");
  __syncthreads();
  if (threadIdx.x == 0) {
    unsigned* bar = b.bar;
    __builtin_amdgcn_s_waitcnt(0);
    unsigned nloc = b.st[0], nx = b.st[1];
    if (nloc == 0u) { xcd_barrier_complete(bar, b.x, nloc, nx); b.st[0] = nloc; b.st[1] = nx; }
    const unsigned old = xb_add(&bar[XB_XSUB(b.x)], 1u);
    const unsigned gen = old / nloc;
    if (old + 1u == (gen + 1u) * nloc) {
      __builtin_amdgcn_fence(__ATOMIC_RELEASE, "agent");
      asm volatile("s_waitcnt vmcnt(0)" ::: "memory");
      const unsigned og = xb_add(&bar[XB_TOP], 1u);
      const unsigned tg = og / nx;
      if (og + 1u == (tg + 1u) * nx) xb_add(&bar[XB_TOPGEN], 1u);
      else XB_SPIN(xb_ld(&bar[XB_TOPGEN]) == tg, bar);
      __builtin_amdgcn_fence(__ATOMIC_ACQUIRE, "agent");
      xb_add(&bar[XB_XGEN(b.x)], 1u);
      asm volatile("s_waitcnt vmcnt(0)" ::: "memory");
    } else {
      XB_SPIN(xb_ld(&bar[XB_XGEN(b.x)]) == gen, bar);
      __builtin_amdgcn_fence(__ATOMIC_ACQUIRE, "agent");
      asm volatile("s_waitcnt vmcnt(0)" ::: "memory");
    }
  }
  __syncthreads();
}

__global__ void __launch_bounds__(NTHREADS, 2) mega(P p) {
  cg::grid_group grid = cg::this_grid();
  __shared__ __attribute__((aligned(16))) char smem[SMEM_BYTES];
  __shared__ int s_item;
  __shared__ __attribute__((aligned(16))) unsigned xb_st[4];
  const int tid = otid(), lane = tid & 63, wid = tid >> 6;
  const int G = gridDim.x, bid = blockIdx.x;
  char* ws = p.ws;
  const float* mod0 = (const float*)(ws + O_MOD);
  const float* mod1 = mod0 + 9 * 6144;
  float* xbuf = p.out + OUT_Y;
  bf16_t* R1 = (bf16_t*)(ws + O_R1);
  unsigned* bar = (unsigned*)(ws + O_BAR);
  if (threadIdx.x < 4) xb_st[threadIdx.x] = 0u;
  __syncthreads();
  const XcdBarrier xb = xcd_barrier_post(bar, (volatile LAS3 unsigned*)xb_st);

  phase0(p, smem);
  grid.sync();
  rownorm_phase(p, nullptr, p.in[13], 0, 0, 1, R1, 0);
  xcd_barrier(xb);
  {
    bf16_t* proj = (bf16_t*)(ws + O_PROJ); float* pab = (float*)(ws + O_PAB); float* conv = p.out + OUT_CONV;
    auto epi = [&](int row, int col, const f32x4& v, const PV& pv) {
      if (col < NPROJ) {
        st_bf4(proj + (size_t)row * NPROJ + col, v);
        if (col < 1536) {
          if (row >= TP - 3 && row < TP) *(f32x4*)(conv + (size_t)(row - (TP - 3)) * 1536 + col) = v;
          else if (row >= TP && ((row - TP) & 15) >= 13) *(f32x4*)(conv + ((size_t)(1 + ((row - TP) >> 4)) * 3 + (((row - TP) & 15) - 13)) * 1536 + col) = v;
        }
      } else if (col < NPROJ + 12) *(f32x4*)(pab + (size_t)row * 16 + (col - NPROJ)) = v;
    };
    for (int t = bid; t < 128 * 15 + 58; t += G) {
      if (t < 128 * 15) {
        const int mt = t / 15, j = t % 15;
        if (j < 14) gemm_tile<0, 256>(R1, D, (const bf16_t*)(ws + O_WIN), D, D, mt * 128, j * 256, smem, nullptr, epi);
        else gemm_tile<0, 128>(R1, D, (const bf16_t*)(ws + O_WIN), D, D, mt * 128, 3584, smem, nullptr, epi);
      } else gemm_tile<0, 64>(R1, D, (const bf16_t*)(ws + O_WIN), D, D, 128 * 128, (t - 128 * 15) * 64, smem, nullptr, epi);
    }
  }
  xcd_barrier(xb);
  for (int t = bid; t < 129 + GITEMS; t += G) {
#if PM & 4
    if (t < GITEMS) gdn_prep_item(p, t, smem); else fox_prep_tile(p, t - GITEMS, smem);
#endif
  }
  xcd_barrier(xb);
  {
  #if PM & 1
    if (bid < 72) gdn_scan_item(p, bid, smem);
#endif
    unsigned* ctr = (unsigned*)(ws + O_CTR);
    for (;;) {
      __syncthreads();
      if (tid == 0) s_item = (int)atomicAdd(ctr, 1u);
      __syncthreads();
      const int it = s_item;
      if (it >= 32 + 512) break;
#if PM & 2
      fox_attn_item(p, it, smem);
#endif
    }
  }
  xcd_barrier(xb);
  {
    const float* oraw = (const float*)(ws + O_ORAW); const bf16_t* proj = (const bf16_t*)(ws + O_PROJ); const float* on = p.in[19];
    for (int row = bid * 4 + wid; row < T; row += G * 4) {
#pragma unroll
      for (int hd = 0; hd < 4; ++hd) {
        const int c = hd * 128 + lane * 2;
        const f32x2 o = *(const f32x2*)(oraw + (size_t)row * 512 + c);
        const float ss = wave_sum(o[0] * o[0] + o[1] * o[1]); const float rs = rsqrtf(ss * (1.f / 128.f) + 1e-6f);
        const unsigned zu = *(const unsigned*)(proj + (size_t)row * NPROJ + 1536 + c);
        *(unsigned*)(R1 + (size_t)row * D + c) = pk2(o[0] * rs * on[lane * 2] * siluf_(bflo(zu)), o[1] * rs * on[lane * 2 + 1] * siluf_(bfhi(zu)));
      }
    }
  }
  xcd_barrier(xb);
  {
    auto pre = [&](int row, int col) { PV o; o.a = *(const f32x4*)(xin_row(p, row) + col); o.b = *(const f32x4*)(mod0 + stream_of(row) * 6144 + 2 * 1024 + col); return o; };
    auto epi = [&](int row, int col, const f32x4& v, const PV& pv) { *(f32x4*)(xbuf + (size_t)row * D + col) = pv.a + pv.b * v; };
    for (int t = bid; t < 512 + 16; t += G) {
      if (t < 512) gemm_tile<0, 256>(R1, D, (const bf16_t*)(ws + O_WOUT), D, D, (t >> 2) * 128, (t & 3) * 256, smem, nullptr, epi, pre);
      else gemm_tile<0, 64>(R1, D, (const bf16_t*)(ws + O_WOUT), D, D, 128 * 128, (t - 512) * 64, smem, nullptr, epi, pre);
    }
  }
  xcd_barrier(xb);
  rownorm_phase(p, xbuf, p.in[14], 0, 3, 4, R1, 0);
  xcd_barrier(xb);
  {
    bf16_t* hid = (bf16_t*)(ws + O_HID);
    auto epi = [&](int row, int col, const f32x4& v, const PV& pv) { f32x4 o; for (int e = 0; e < 4; ++e) { const float rl = fmaxf(v[e], 0.f); o[e] = rl * rl; } st_bf4(hid + (size_t)row * DFF + col, o); };
    for (int t = bid; t < 2048 + 64; t += G) {
      if (t < 2048) gemm_tile<0, 256>(R1, D, (const bf16_t*)(ws + O_FF1_0), D, D, (t >> 4) * 128, (t & 15) * 256, smem, nullptr, epi);
      else gemm_tile<0, 64>(R1, D, (const bf16_t*)(ws + O_FF1_0), D, D, 128 * 128, (t - 2048) * 64, smem, nullptr, epi);
    }
  }
  xcd_barrier(xb);
  {
    auto pre = [&](int row, int col) { PV o; o.a = *(const f32x4*)(xbuf + (size_t)row * D + col); o.b = *(const f32x4*)(mod0 + stream_of(row) * 6144 + 5 * 1024 + col); return o; };
    auto epi = [&](int row, int col, const f32x4& v, const PV& pv) { *(f32x4*)(xbuf + (size_t)row * D + col) = pv.a + pv.b * v; };
    for (int t = bid; t < 512 + 16; t += G) {
      if (t < 512) gemm_tile<0, 256>((const bf16_t*)(ws + O_HID), DFF, (const bf16_t*)(ws + O_FF2_0), DFF, DFF, (t >> 2) * 128, (t & 3) * 256, smem, nullptr, epi, pre);
      else gemm_tile<0, 64>((const bf16_t*)(ws + O_HID), DFF, (const bf16_t*)(ws + O_FF2_0), DFF, DFF, 128 * 128, (t - 512) * 64, smem, nullptr, epi, pre);
    }
  }
  xcd_barrier(xb);
  rownorm_phase(p, xbuf, p.in[28], 1, 0, 1, R1, 1);
  xcd_barrier(xb);
  {
    bf16_t* rkvb = (bf16_t*)(ws + O_RKVB); bf16_t* lw = (bf16_t*)(ws + O_LW); bf16_t* la = (bf16_t*)(ws + O_LA); bf16_t* lg = (bf16_t*)(ws + O_LG);
    auto epi_rkv = [&](int row, int col, const f32x4& v, const PV& pv) { st_bf4(rkvb + (size_t)row * 3072 + col, v); };
    for (int t = bid; t < 128 * 16 + 56; t += G) {
      int m0, n0, kind;
      if (t < 128 * 16) { const int j = t & 15; m0 = (t >> 4) * 128; if (j < 12) { n0 = j * 256; kind = 0; } else { n0 = 3072 + (j - 12) * 128; kind = 1; } }
      else { m0 = 128 * 128; n0 = (t - 128 * 16) * 64; kind = 2; }
      if (n0 < 3072) {
        const int g = n0 >> 10; const int mui = g == 0 ? 0 : (g == 1 ? 2 : 3);
        if (kind == 0) gemm_tile<1, 256>(R1, D, (const bf16_t*)(ws + O_RKV), D, D, m0, n0, smem, p.in[30] + mui * 1024, epi_rkv);
        else gemm_tile<1, 64>(R1, D, (const bf16_t*)(ws + O_RKV), D, D, m0, n0, smem, p.in[30] + mui * 1024, epi_rkv);
      } else {
        const int nt = 24 + ((n0 - 3072) >> 7);
        const int mui = nt == 24 ? 1 : (nt == 25 ? 4 : 5);
        auto epi = [&](int row, int col, const f32x4& v, const PV& pv) {
          if (nt == 24) { if (col < 64) { const f32x4 o = {tanhf(v[0]), tanhf(v[1]), tanhf(v[2]), tanhf(v[3])}; st_bf4(lw + (size_t)row * 64 + col, o); } }
          else if (nt == 25) { const int c = col - 128; if (c < 64) st_bf4(la + (size_t)row * 64 + c, v); }
          else { const int c = col - 256; if (c < 192) { f32x4 o = {0.f, 0.f, 0.f, 0.f}; if (c < 160) o = (f32x4){sigmoidf_(v[0]), sigmoidf_(v[1]), sigmoidf_(v[2]), sigmoidf_(v[3])}; st_bf4(lg + (size_t)row * 192 + c, o); } }
        };
        if (kind == 1) gemm_tile<1, 128>(R1, D, (const bf16_t*)(ws + O_LORA1), D, D, m0, n0 - 3072, smem, p.in[30] + mui * 1024, epi);
        else gemm_tile<1, 64>(R1, D, (const bf16_t*)(ws + O_LORA1), D, D, m0, n0 - 3072, smem, p.in[30] + mui * 1024, epi);
      }
    }
  }
  xcd_barrier(xb);
  {
    float* dec = (float*)(ws + O_DEC); bf16_t* abuf = (bf16_t*)(ws + O_AB); bf16_t* gate = (bf16_t*)(ws + O_GATE);
    const float* w0 = p.in[34]; const float* a0 = p.in[37];
    for (int t = bid; t < 129 * 24; t += G) {
      const int mt = t / 24, nt = t % 24, g = nt >> 3, n0 = (nt & 7) * 128;
      if (g == 0) {
        auto pre = [&](int row, int col) { PV o; o.a = *(const f32x4*)(w0 + col); o.b = o.a; return o; };
        auto epi = [&](int row, int col, const f32x4& v, const PV& pv) { f32x4 o; for (int e = 0; e < 4; ++e) { const float wl = -softplusf_(-(pv.a[e] + v[e])) - 0.5f; o[e] = __expf(-__expf(wl)); } *(f32x4*)(dec + (size_t)row * D + col) = o; };
        gemm_tile<0>((const bf16_t*)(ws + O_LW), 64, (const bf16_t*)(ws + O_W2), 64, 64, mt * 128, n0, smem, nullptr, epi, pre);
      } else if (g == 1) {
        auto pre = [&](int row, int col) { PV o; o.a = *(const f32x4*)(a0 + col); o.b = o.a; return o; };
        auto epi = [&](int row, int col, const f32x4& v, const PV& pv) { f32x4 o; for (int e = 0; e < 4; ++e) o[e] = sigmoidf_(pv.a[e] + v[e]); st_bf4(abuf + (size_t)row * D + col, o); };
        gemm_tile<0>((const bf16_t*)(ws + O_LA), 64, (const bf16_t*)(ws + O_A2), 64, 64, mt * 128, n0, smem, nullptr, epi, pre);
      } else {
        auto epi = [&](int row, int col, const f32x4& v, const PV& pv) { st_bf4(gate + (size_t)row * D + col, v); };
        gemm_tile<0>((const bf16_t*)(ws + O_LG), 192, (const bf16_t*)(ws + O_G2), 192, 192, mt * 128, n0, smem, nullptr, epi);
      }
    }
  }
  xcd_barrier(xb);
#if PM & 8
  if (G > 256) {
    if (bid < 256) wkv_scan_item(p, bid, smem);
    else for (int it = 256 + (bid - 256); it < 256 + 2048; it += G - 256) wkv_scan_item(p, it, smem);
  } else {
    for (int it = bid; it < 256 + 2048; it += G) wkv_scan_item(p, it, smem);
  }
#endif
  xcd_barrier(xb);
  {
    const bf16_t* yraw = R1; const bf16_t* rkvb = (const bf16_t*)(ws + O_RKVB); const bf16_t* abuf = (const bf16_t*)(ws + O_AB);
    const bf16_t* gate = (const bf16_t*)(ws + O_GATE); bf16_t* ybf = (bf16_t*)(ws + O_DEC);
    const float* ka = p.in[43]; const float* rk = p.in[44]; const float* lnw = p.in[45]; const float* lnb = p.in[46];
    for (int row = bid * 4 + wid; row < T; row += G * 4) {
      const int c0 = lane * 16;
      u32x4 yv[2], rv[2], kv[2], vv[2], av[2], gv[2];
#pragma unroll
      for (int q = 0; q < 2; ++q) {
        yv[q] = *(const u32x4*)(yraw + (size_t)row * D + c0 + 8 * q);
        rv[q] = *(const u32x4*)(rkvb + (size_t)row * 3072 + c0 + 8 * q);
        kv[q] = *(const u32x4*)(rkvb + (size_t)row * 3072 + 1024 + c0 + 8 * q);
        vv[q] = *(const u32x4*)(rkvb + (size_t)row * 3072 + 2048 + c0 + 8 * q);
        av[q] = *(const u32x4*)(abuf + (size_t)row * D + c0 + 8 * q);
        gv[q] = *(const u32x4*)(gate + (size_t)row * D + c0 + 8 * q);
      }
      float y[16]; float sum = 0.f, bs = 0.f;
#pragma unroll
      for (int e = 0; e < 16; ++e) {
        const unsigned yu = yv[e >> 3][(e >> 1) & 3], ru = rv[e >> 3][(e >> 1) & 3], ku = kv[e >> 3][(e >> 1) & 3], au = av[e >> 3][(e >> 1) & 3];
        const float yy = (e & 1) ? bfhi(yu) : bflo(yu), rr = (e & 1) ? bfhi(ru) : bflo(ru), kk = (e & 1) ? bfhi(ku) : bflo(ku), aa = (e & 1) ? bfhi(au) : bflo(au);
        y[e] = yy; sum += yy;
        const float kp = kk * (1.f + (aa - 1.f) * ka[c0 + e]);
        bs += rr * kp * rk[c0 + e];
      }
      sum = dpp_add(sum, 0); sum = dpp_add(sum, 1);
      bs = dpp_add(bs, 0); bs = dpp_add(bs, 1);
      const float mean = sum * (1.f / 64.f);
      float vs_ = 0.f;
#pragma unroll
      for (int e = 0; e < 16; ++e) { const float d = y[e] - mean; vs_ += d * d; }
      vs_ = dpp_add(vs_, 0); vs_ = dpp_add(vs_, 1);
      const float rstd = rsqrtf(vs_ * (1.f / 64.f) + 64e-5f);
      u32x4 ov[2];
#pragma unroll
      for (int e = 0; e < 16; e += 2) {
        float o2[2];
#pragma unroll
        for (int f = 0; f < 2; ++f) {
          const int ee = e + f;
          const unsigned vu = vv[ee >> 3][(ee >> 1) & 3], gu = gv[ee >> 3][(ee >> 1) & 3];
          const float vvv = (ee & 1) ? bfhi(vu) : bflo(vu), gg = (ee & 1) ? bfhi(gu) : bflo(gu);
          const float yn = (y[ee] - mean) * rstd * lnw[c0 + ee] + lnb[c0 + ee];
          o2[f] = (yn + bs * vvv) * gg;
        }
        ov[e >> 3][(e >> 1) & 3] = pk2(o2[0], o2[1]);
      }
      *(u32x4*)(ybf + (size_t)row * D + c0) = ov[0];
      *(u32x4*)(ybf + (size_t)row * D + c0 + 8) = ov[1];
    }
  }
  xcd_barrier(xb);
  {
    auto pre = [&](int row, int col) { PV o; o.a = *(const f32x4*)(xbuf + (size_t)row * D + col); o.b = *(const f32x4*)(mod1 + stream_of(row) * 6144 + 2 * 1024 + col); return o; };
    auto epi = [&](int row, int col, const f32x4& v, const PV& pv) { *(f32x4*)(xbuf + (size_t)row * D + col) = pv.a + pv.b * v; };
    for (int t = bid; t < 512 + 16; t += G) {
      if (t < 512) gemm_tile<0, 256>((const bf16_t*)(ws + O_DEC), D, (const bf16_t*)(ws + O_WO), D, D, (t >> 2) * 128, (t & 3) * 256, smem, nullptr, epi, pre);
      else gemm_tile<0, 64>((const bf16_t*)(ws + O_DEC), D, (const bf16_t*)(ws + O_WO), D, D, 128 * 128, (t - 512) * 64, smem, nullptr, epi, pre);
    }
  }
  xcd_barrier(xb);
  rownorm_phase(p, xbuf, p.in[29], 1, 3, 4, R1, 0);
  xcd_barrier(xb);
  {
    bf16_t* hid = (bf16_t*)(ws + O_HID);
    auto epi = [&](int row, int col, const f32x4& v, const PV& pv) { f32x4 o; for (int e = 0; e < 4; ++e) { const float rl = fmaxf(v[e], 0.f); o[e] = rl * rl; } st_bf4(hid + (size_t)row * DFF + col, o); };
    for (int t = bid; t < 2048 + 64; t += G) {
      if (t < 2048) gemm_tile<0, 256>(R1, D, (const bf16_t*)(ws + O_FF1_1), D, D, (t >> 4) * 128, (t & 15) * 256, smem, nullptr, epi);
      else gemm_tile<0, 64>(R1, D, (const bf16_t*)(ws + O_FF1_1), D, D, 128 * 128, (t - 2048) * 64, smem, nullptr, epi);
    }
  }
  xcd_barrier(xb);
  {
    auto pre = [&](int row, int col) { PV o; o.a = *(const f32x4*)(xbuf + (size_t)row * D + col); o.b = *(const f32x4*)(mod1 + stream_of(row) * 6144 + 5 * 1024 + col); return o; };
    auto epi = [&](int row, int col, const f32x4& v, const PV& pv) { *(f32x4*)(xbuf + (size_t)row * D + col) = pv.a + pv.b * v; };
    for (int t = bid; t < 512 + 16; t += G) {
      if (t < 512) gemm_tile<0, 256>((const bf16_t*)(ws + O_HID), DFF, (const bf16_t*)(ws + O_FF2_1), DFF, DFF, (t >> 2) * 128, (t & 3) * 256, smem, nullptr, epi, pre);
      else gemm_tile<0, 64>((const bf16_t*)(ws + O_HID), DFF, (const bf16_t*)(ws + O_FF2_1), DFF, DFF, 128 * 128, (t - 512) * 64, smem, nullptr, epi, pre);
    }
  }
}

extern "C" void kernel_launch(void* const* d_in, const int* in_sizes, int n_in, void* d_out, int out_size, void* d_ws, size_t ws_size,
                              hipStream_t stream) {
  static int grid_blocks = 0;
  if (!grid_blocks) {
    int dev = 0, cus = 0, per_cu = 0;
    hipGetDevice(&dev);
    hipDeviceGetAttribute(&cus, hipDeviceAttributeMultiprocessorCount, dev);
    hipOccupancyMaxActiveBlocksPerMultiprocessor(&per_cu, mega, NTHREADS, 0);
    if (per_cu > 2) per_cu = 2;
    grid_blocks = cus * per_cu;
    if (ws_size < WS_NEED) fprintf(stderr, "workspace too small: %zu < %zu\n", ws_size, (size_t)WS_NEED);
  }
  P p{};
  for (int i = 0; i < 50; ++i) p.in[i] = (const float*)d_in[i];
  p.out = (float*)d_out;
  p.ws = (char*)d_ws;
  (void)hipMemsetAsync((char*)d_ws + O_BAR, 0, 16384, stream);
  void* args[] = {&p};
  hipError_t e = hipLaunchCooperativeKernel((void*)mega, dim3(grid_blocks), dim3(NTHREADS), args, 0, stream);
  if (e != hipSuccess) fprintf(stderr, "cooperative launch failed: %s (grid %d)\n", hipGetErrorString(e), grid_blocks);
}
```
